# Optimizing an MI355X kernel written in HIP

```python
import math
import jax, jax.numpy as jnp
from jax import lax
import numpy as np

D_MODEL = 1024
BATCH = 16
SEQ = 2048
DEPTH = 4

N_MIXERS = 3
D_INNER = D_MODEL
HEAD_DIM = 128
HGRN_HEADS = D_INNER // HEAD_DIM
HGRN_CHUNK = 64
MOBA_HEADS = D_INNER // HEAD_DIM
MOBA_BLOCK = 256
MOBA_TOPK = 3
MOBA_QCHUNK = 32
ROPE_THETA = 10000.0
S5_GROUP = 16
S5_GROUPS = D_INNER // S5_GROUP
S5_STATE = 64
DEEPNORM_ALPHA = (2 * DEPTH) ** 0.25
DEEPNORM_BETA = (8 * DEPTH) ** -0.25
LN_EPS = 1e-5
RMS_EPS = 1e-6
NEG = -1e30

kernel_name = "hybrid_hgrn2_moba_s5_deepnorm"


def layer_norm(x, g, b):
    xf = x.astype(jnp.float32)
    mu = jnp.mean(xf, axis=-1, keepdims=True)
    var = jnp.mean(jnp.square(xf - mu), axis=-1, keepdims=True)
    y = (xf - mu) * lax.rsqrt(var + LN_EPS) * g.astype(jnp.float32) + b.astype(jnp.float32)
    return y.astype(x.dtype)


def hgrn2_lower_bounds(lb_logits):
    sm = jax.nn.softmax(lb_logits.astype(jnp.float32), axis=0)
    return jnp.cumsum(sm, axis=0) - sm[0:1]


def hgrn2_chunk_scan(q, k, v, logf):
    bsz, s, h, dk = q.shape
    dv = v.shape[-1]
    n = s // HGRN_CHUNK

    def to_chunks(t):
        return t.reshape(bsz, n, HGRN_CHUNK, h, t.shape[-1]).transpose(1, 0, 3, 2, 4)

    causal = jnp.tril(jnp.ones((HGRN_CHUNK, HGRN_CHUNK), dtype=bool))

    def step(state, inp):
        qc, kc, vc, gc = inp
        bcum = jnp.cumsum(gc, axis=2)
        diff = bcum[:, :, :, None, :] - bcum[:, :, None, :, :]
        decay = jnp.exp(jnp.where(causal[:, :, None], diff, -jnp.inf))
        scores = jnp.einsum('bhtk,bhtsk,bhsk->bhts', qc, decay, kc)
        o = jnp.einsum('bhts,bhsv->bhtv', scores, vc) + \
            jnp.einsum('bhtk,bhkv->bhtv', qc * jnp.exp(bcum), state)
        b_last = bcum[:, :, -1:, :]
        state = jnp.exp(b_last[:, :, 0, :])[..., None] * state + \
            jnp.einsum('bhsk,bhsv->bhkv', kc * jnp.exp(b_last - bcum), vc)
        return state, o

    state0 = jnp.zeros((bsz, h, dk, dv), jnp.float32)
    _, o = lax.scan(step, state0, (to_chunks(q), to_chunks(k), to_chunks(v), to_chunks(logf)))
    return o.transpose(1, 0, 3, 2, 4).reshape(bsz, s, h, dv)


def hgrn2_mixer(x, w_in, norm_g, w_out, lb):
    bsz, s, _ = x.shape
    q, zf, v, gate = jnp.split(x @ w_in, 4, axis=-1)
    shp = (bsz, s, HGRN_HEADS, HEAD_DIM)
    q = jax.nn.silu(q.astype(jnp.float32)).reshape(shp)
    v = v.astype(jnp.float32).reshape(shp)
    lbh = lb.reshape(HGRN_HEADS, HEAD_DIM)
    f = lbh + (1.0 - lbh) * jax.nn.sigmoid(zf.astype(jnp.float32).reshape(shp))
    logf = jnp.log(f)
    k = -jnp.expm1(logf)
    o = hgrn2_chunk_scan(q, k, v, logf)
    o = o * lax.rsqrt(jnp.mean(jnp.square(o), -1, keepdims=True) + RMS_EPS) * \
        norm_g.astype(jnp.float32).reshape(HGRN_HEADS, HEAD_DIM)
    o = o.reshape(bsz, s, D_INNER) * jax.nn.silu(gate.astype(jnp.float32))
    return o.astype(x.dtype) @ w_out


def rope(t, cos, sin):
    half = t.shape[-1] // 2
    t1, t2 = t[..., :half], t[..., half:]
    return jnp.concatenate([t1 * cos - t2 * sin, t2 * cos + t1 * sin], axis=-1)


def moba_attention(q, k, v):
    bsz, h, s, d = q.shape
    nb = -(-s // MOBA_BLOCK)
    s_pad = nb * MOBA_BLOCK
    pad = ((0, 0), (0, 0), (0, s_pad - s), (0, 0))
    qb = jnp.pad(q, pad).reshape(bsz, h, nb, MOBA_BLOCK, d)
    kb = jnp.pad(k, pad).reshape(bsz, h, nb, MOBA_BLOCK, d)
    vb = jnp.pad(v, pad).reshape(bsz, h, nb, MOBA_BLOCK, d)

    k_mean = jnp.mean(kb, axis=3)
    gate = jnp.einsum('bhtd,bhnd->bhtn', q, k_mean)
    q_blk = jnp.arange(s) // MOBA_BLOCK
    past = jnp.arange(nb)[None, :] < q_blk[:, None]
    gate = jnp.where(past, gate, -jnp.inf)
    topk = min(MOBA_TOPK, nb)
    top_val, top_idx = lax.top_k(gate, topk)
    sel_valid = jnp.isfinite(top_val)

    nqc = s // MOBA_QCHUNK

    def to_qchunks(t):
        return t.reshape(bsz, h, nqc, MOBA_QCHUNK, t.shape[-1]).transpose(0, 2, 1, 3, 4) \
            .reshape(bsz * nqc, h, MOBA_QCHUNK, t.shape[-1])

    b_ids = jnp.repeat(jnp.arange(bsz), nqc)
    h_ids = jnp.arange(h)[:, None, None]

    def past_chunk(args):
        qc, ic, mc, bi = args
        kg = kb[bi][h_ids, ic]
        vg = vb[bi][h_ids, ic]
        sc = jnp.einsum('hqd,hqjsd->hqjs', qc, kg)
        sc = jnp.where(mc[..., None], sc, NEG)
        m = jnp.max(sc, axis=(2, 3))
        p = jnp.exp(sc - m[..., None, None]) * mc[..., None]
        return m, jnp.sum(p, axis=(2, 3)), jnp.einsum('hqjs,hqjsd->hqd', p, vg)

    m_p, l_p, acc_p = lax.map(past_chunk, (to_qchunks(q), to_qchunks(top_idx),
                                           to_qchunks(sel_valid), b_ids))
    m_p = m_p.reshape(bsz, nqc, h, MOBA_QCHUNK).transpose(0, 2, 1, 3).reshape(bsz, h, s)
    l_p = l_p.reshape(bsz, nqc, h, MOBA_QCHUNK).transpose(0, 2, 1, 3).reshape(bsz, h, s)
    acc_p = acc_p.reshape(bsz, nqc, h, MOBA_QCHUNK, d).transpose(0, 2, 1, 3, 4).reshape(bsz, h, s, d)

    causal = jnp.tril(jnp.ones((MOBA_BLOCK, MOBA_BLOCK), dtype=bool))
    s_o = jnp.where(causal, jnp.einsum('bhnqd,bhnsd->bhnqs', qb, kb), NEG)
    m_o = jnp.max(s_o, axis=-1)
    p_o = jnp.exp(s_o - m_o[..., None])
    l_o = jnp.sum(p_o, axis=-1).reshape(bsz, h, s_pad)[:, :, :s]
    acc_o = jnp.einsum('bhnqs,bhnsd->bhnqd', p_o, vb).reshape(bsz, h, s_pad, d)[:, :, :s]
    m_o = m_o.reshape(bsz, h, s_pad)[:, :, :s]

    m = jnp.maximum(m_p, m_o)
    a_p = jnp.exp(m_p - m)
    a_o = jnp.exp(m_o - m)
    return (acc_p * a_p[..., None] + acc_o * a_o[..., None]) / (l_p * a_p + l_o * a_o)[..., None]


def moba_mixer(x, w_in, w_out):
    bsz, s, _ = x.shape
    q, k, v, gate = jnp.split(x @ w_in, 4, axis=-1)
    shp = (bsz, s, MOBA_HEADS, HEAD_DIM)
    q = q.astype(jnp.float32).reshape(shp)
    k = k.astype(jnp.float32).reshape(shp)
    v = v.astype(jnp.float32).reshape(shp)
    pos = jnp.arange(s, dtype=jnp.float32)
    inv_freq = 1.0 / (ROPE_THETA ** (jnp.arange(0, HEAD_DIM, 2, dtype=jnp.float32) / HEAD_DIM))
    ang = pos[:, None] * inv_freq[None, :]
    cos, sin = jnp.cos(ang)[:, None, :], jnp.sin(ang)[:, None, :]
    q = rope(q, cos, sin) * (HEAD_DIM ** -0.5)
    k = rope(k, cos, sin)
    o = moba_attention(q.transpose(0, 2, 1, 3), k.transpose(0, 2, 1, 3), v.transpose(0, 2, 1, 3))
    o = o.transpose(0, 2, 1, 3).reshape(bsz, s, D_INNER) * jax.nn.silu(gate.astype(jnp.float32))
    return o.astype(x.dtype) @ w_out


def s5_mixer(x, w_in, a_re, a_im, log_dt, b_re, b_im, c_re, c_im, d_skip, w_glu, b_glu, w_out):
    bsz, s, _ = x.shape
    u, gate = jnp.split(x @ w_in, 2, axis=-1)
    u32 = u.astype(jnp.float32)
    ar, ai = a_re.astype(jnp.float32), a_im.astype(jnp.float32)
    dt = jnp.exp(log_dt.astype(jnp.float32))[:, None]
    mag = jnp.exp(dt * ar)
    abar_re, abar_im = mag * jnp.cos(dt * ai), mag * jnp.sin(dt * ai)
    nr, ni = abar_re - 1.0, abar_im
    den = ar * ar + ai * ai
    z_re = (nr * ar + ni * ai) / den
    z_im = (ni * ar - nr * ai) / den
    br, bi = b_re.astype(jnp.float32), b_im.astype(jnp.float32)
    bbar_re = z_re[..., None] * br - z_im[..., None] * bi
    bbar_im = z_re[..., None] * bi + z_im[..., None] * br
    cr, ci = c_re.astype(jnp.float32), c_im.astype(jnp.float32)

    def combine(e1, e2):
        a1r, a1i, b1r, b1i = e1
        a2r, a2i, b2r, b2i = e2
        return (a2r * a1r - a2i * a1i, a2r * a1i + a2i * a1r,
                a2r * b1r - a2i * b1i + b2r, a2r * b1i + a2i * b1r + b2i)

    def scan_one(u_b):
        bu_re = jnp.einsum('gph,sgh->sgp', bbar_re, u_b)
        bu_im = jnp.einsum('gph,sgh->sgp', bbar_im, u_b)
        ar_s = jnp.broadcast_to(abar_re, bu_re.shape)
        ai_s = jnp.broadcast_to(abar_im, bu_re.shape)
        _, _, hr, hi = lax.associative_scan(combine, (ar_s, ai_s, bu_re, bu_im), axis=0)
        return jnp.einsum('ghp,sgp->sgh', cr, hr) - jnp.einsum('ghp,sgp->sgh', ci, hi)

    y = lax.map(scan_one, u32.reshape(bsz, s, S5_GROUPS, S5_GROUP)).reshape(bsz, s, D_INNER)
    y = y + d_skip.astype(jnp.float32) * u32
    y = jax.nn.gelu(y)
    y = y * jax.nn.sigmoid(y @ w_glu.astype(jnp.float32) + b_glu.astype(jnp.float32))
    y = y * jax.nn.silu(gate.astype(jnp.float32))
    return y.astype(x.dtype) @ w_out


def setup_inputs(seed: int = 0) -> dict:
    key = jax.random.key(seed)
    keys = iter(jax.random.split(key, 64))
    f32 = jnp.float32

    def nrm(shape, scale):
        return jax.random.normal(next(keys), shape, f32) * scale

    inp = {}
    inp["x"] = nrm((BATCH, SEQ, D_MODEL), 1.0)
    inp["hgrn_lower_bounds"] = nrm((DEPTH, D_INNER), 0.1)
    w_out_scale = DEEPNORM_BETA * D_INNER ** -0.5
    for i in range(DEPTH):
        kind = i % N_MIXERS
        p = f"l{i}_"
        if kind == 0:
            inp[p + "w_in"] = nrm((D_MODEL, 4 * D_INNER), D_MODEL ** -0.5)
            inp[p + "norm_g"] = 1.0 + nrm((D_INNER,), 0.02)
            inp[p + "w_out"] = nrm((D_INNER, D_MODEL), w_out_scale)
        elif kind == 1:
            inp[p + "w_in"] = nrm((D_MODEL, 4 * D_INNER), D_MODEL ** -0.5)
            inp[p + "w_out"] = nrm((D_INNER, D_MODEL), w_out_scale)
        else:
            inp[p + "w_in"] = nrm((D_MODEL, 2 * D_INNER), D_MODEL ** -0.5)
            inp[p + "a_re"] = -0.5 + nrm((S5_GROUPS, S5_STATE), 0.01)
            inp[p + "a_im"] = math.pi * jnp.broadcast_to(jnp.arange(S5_STATE, dtype=f32), (S5_GROUPS, S5_STATE)) \
                + nrm((S5_GROUPS, S5_STATE), 0.01)
            inp[p + "log_dt"] = jax.random.uniform(next(keys), (S5_GROUPS,), f32,
                                                   minval=math.log(1e-3), maxval=math.log(1e-1))
            inp[p + "b_re"] = nrm((S5_GROUPS, S5_STATE, S5_GROUP), (2 * S5_GROUP) ** -0.5)
            inp[p + "b_im"] = nrm((S5_GROUPS, S5_STATE, S5_GROUP), (2 * S5_GROUP) ** -0.5)
            inp[p + "c_re"] = nrm((S5_GROUPS, S5_GROUP, S5_STATE), (2 * S5_STATE) ** -0.5)
            inp[p + "c_im"] = nrm((S5_GROUPS, S5_GROUP, S5_STATE), (2 * S5_STATE) ** -0.5)
            inp[p + "d"] = nrm((D_INNER,), 1.0)
            inp[p + "w_glu"] = nrm((D_INNER, D_INNER), D_INNER ** -0.5)
            inp[p + "b_glu"] = nrm((D_INNER,), 0.01)
            inp[p + "w_out"] = nrm((D_INNER, D_MODEL), w_out_scale)
        inp[p + "ln_g"] = 1.0 + nrm((D_MODEL,), 0.02)
        inp[p + "ln_b"] = nrm((D_MODEL,), 0.01)
    return inp


def reference(x, hgrn_lower_bounds,
              l0_w_in, l0_norm_g, l0_w_out, l0_ln_g, l0_ln_b,
              l1_w_in, l1_w_out, l1_ln_g, l1_ln_b,
              l2_w_in, l2_a_re, l2_a_im, l2_log_dt, l2_b_re, l2_b_im, l2_c_re, l2_c_im,
              l2_d, l2_w_glu, l2_b_glu, l2_w_out, l2_ln_g, l2_ln_b,
              l3_w_in, l3_norm_g, l3_w_out, l3_ln_g, l3_ln_b):
    lbs = hgrn2_lower_bounds(hgrn_lower_bounds)
    layers = [
        dict(w_in=l0_w_in, norm_g=l0_norm_g, w_out=l0_w_out, ln_g=l0_ln_g, ln_b=l0_ln_b),
        dict(w_in=l1_w_in, w_out=l1_w_out, ln_g=l1_ln_g, ln_b=l1_ln_b),
        dict(w_in=l2_w_in, a_re=l2_a_re, a_im=l2_a_im, log_dt=l2_log_dt, b_re=l2_b_re, b_im=l2_b_im,
             c_re=l2_c_re, c_im=l2_c_im, d=l2_d, w_glu=l2_w_glu, b_glu=l2_b_glu, w_out=l2_w_out,
             ln_g=l2_ln_g, ln_b=l2_ln_b),
        dict(w_in=l3_w_in, norm_g=l3_norm_g, w_out=l3_w_out, ln_g=l3_ln_g, ln_b=l3_ln_b),
    ]
    for i in range(DEPTH):
        p = layers[i]
        kind = i % N_MIXERS
        if kind == 0:
            y = hgrn2_mixer(x, p["w_in"], p["norm_g"], p["w_out"], lbs[i])
        elif kind == 1:
            y = moba_mixer(x, p["w_in"], p["w_out"])
        else:
            y = s5_mixer(x, p["w_in"], p["a_re"], p["a_im"], p["log_dt"], p["b_re"], p["b_im"],
                         p["c_re"], p["c_im"], p["d"], p["w_glu"], p["b_glu"], p["w_out"])
        x = layer_norm(DEEPNORM_ALPHA * x + y, p["ln_g"], p["ln_b"])
    return x
```

```cpp
#include <hip/hip_runtime.h>
#include <hip/hip_cooperative_groups.h>
#include <cstdio>
namespace cg = cooperative_groups;

#ifndef MODE_SINGLE
#define MODE_SINGLE 1
#endif
#ifndef EN_L0
#define EN_L0 1
#endif
#ifndef EN_L1
#define EN_L1 1
#endif
#ifndef EN_L2
#define EN_L2 1
#endif
#ifndef EN_L3
#define EN_L3 1
#endif

#ifndef PHMASK
#define PHMASK 0x3ffff
#endif
#define PH_ON(k) (((PHMASK) >> (k)) & 1)
#define LAS __attribute__((address_space(3)))
typedef unsigned short bf16_t;
typedef short bf16x8 __attribute__((ext_vector_type(8)));
typedef float f32x4 __attribute__((ext_vector_type(4)));
typedef unsigned u32x4 __attribute__((ext_vector_type(4)));
typedef unsigned u32x2 __attribute__((ext_vector_type(2)));

constexpr int SEQ = 2048, DM = 1024, NTOK = 32768;
constexpr int LDS_BYTES = 152576 + 16;
constexpr float ALPHA = 1.681792830507429f;
constexpr int NPHASE = 18;

struct P {
    const float* x; const float* lbl;
    const float* w_in[4]; const float* w_out[4]; const float* ln_g[4]; const float* ln_b[4]; const float* norm_g[4];
    const float *a_re, *a_im, *log_dt, *b_re, *b_im, *c_re, *c_im, *dskip, *w_glu, *b_glu;
    float* out;
    bf16_t* wt_in[4]; bf16_t* wt_out[4]; bf16_t* wt_glu;
    bf16_t* xb; float* xf; bf16_t* s[4];
    float* lb; float* rope; float* kmean; float* a16; float* lnx; unsigned* lncnt; unsigned* bar; bf16_t* ab; bf16_t* xlo;
    bf16_t* s5w1; bf16_t* s5t; bf16_t* s5w2;
    int ph_lo, ph_hi;
};

__device__ __forceinline__ unsigned pk(float lo, float hi) { unsigned r; asm("v_cvt_pk_bf16_f32 %0, %1, %2" : "=v"(r) : "v"(lo), "v"(hi)); return r; }
__device__ __forceinline__ bf16_t f2bf(float v) { return (bf16_t)(pk(v, 0.f) & 0xffffu); }
__device__ __forceinline__ float bf2f(bf16_t u) { return __uint_as_float(((unsigned)u) << 16); }
__device__ __forceinline__ float blo(unsigned w) { return __uint_as_float(w << 16); }
__device__ __forceinline__ float bhi(unsigned w) { return __uint_as_float(w & 0xffff0000u); }
__device__ __forceinline__ u32x4 pack8(f32x4 a, f32x4 b) { u32x4 w; w.x = pk(a[0], a[1]); w.y = pk(a[2], a[3]); w.z = pk(b[0], b[1]); w.w = pk(b[2], b[3]); return w; }
__device__ __forceinline__ u32x2 pack4(f32x4 a) { u32x2 w; w.x = pk(a[0], a[1]); w.y = pk(a[2], a[3]); return w; }
__device__ __forceinline__ float sigmoidf_(float v) { return __builtin_amdgcn_rcpf(1.0f + __builtin_amdgcn_exp2f(-1.4426950408889634f * v)); }
__device__ __forceinline__ float siluf_(float v) { return v * __builtin_amdgcn_rcpf(1.0f + __builtin_amdgcn_exp2f(-1.4426950408889634f * v)); }
__device__ __forceinline__ float geluf_(float v) { const float u = -2.3022081943418046f * (v + 0.044715f * v * v * v); return v * __builtin_amdgcn_rcpf(1.0f + __builtin_amdgcn_exp2f(u)); }
__device__ __forceinline__ float xmax_16_32(float x) {
    auto a = __builtin_amdgcn_permlane16_swap(__float_as_uint(x), __float_as_uint(x), false, false);
    const float y = fmaxf(__uint_as_float(a[0]), __uint_as_float(a[1]));
    auto b = __builtin_amdgcn_permlane32_swap(__float_as_uint(y), __float_as_uint(y), false, false);
    return fmaxf(__uint_as_float(b[0]), __uint_as_float(b[1]));
}
__device__ __forceinline__ float xsum_16_32(float x) {
    auto a = __builtin_amdgcn_permlane16_swap(__float_as_uint(x), __float_as_uint(x), false, false);
    const float y = __uint_as_float(a[0]) + __uint_as_float(a[1]);
    auto b = __builtin_amdgcn_permlane32_swap(__float_as_uint(y), __float_as_uint(y), false, false);
    return __uint_as_float(b[0]) + __uint_as_float(b[1]);
}
__device__ __forceinline__ f32x4 mfma16(bf16x8 a, bf16x8 b, f32x4 c) { return __builtin_amdgcn_mfma_f32_16x16x32_bf16(a, b, c, 0, 0, 0); }


#define XB_TMO      128
#define XB_XCNT(j)  (256  + 64 * (j))
#define XB_XSUB(j)  (1280 + 64 * (j))
#define XB_XGEN(j)  (2304 + 64 * (j))
#define XB_TOP      3328
#define XB_TOPGEN   3392
#define XCD_BAR_WORDS 3456
#define XB_SPIN_CAP (1u << 18)
__device__ __forceinline__ unsigned xb_ld(unsigned* p)              { return __hip_atomic_load(p, __ATOMIC_RELAXED, __HIP_MEMORY_SCOPE_AGENT); }
__device__ __forceinline__ unsigned xb_add(unsigned* p, unsigned v) { return __hip_atomic_fetch_add(p, v, __ATOMIC_RELAXED, __HIP_MEMORY_SCOPE_AGENT); }
__device__ __forceinline__ unsigned xb_xcc_id() { return (unsigned)__builtin_amdgcn_s_getreg((3 << 11) | 20) & 0xFu; }
#define XB_SPIN(cond, bar) do { unsigned _sp = 0; while (cond) { __builtin_amdgcn_s_sleep(1); \
    if ((++_sp & 255u) == 0u) { if (xb_ld(&(bar)[XB_TMO])) break; if (_sp > XB_SPIN_CAP) { atomicAdd(&(bar)[XB_TMO], 1u); break; } } } } while (0)
struct XcdBarrier { unsigned* bar; unsigned x; volatile LAS unsigned* st; };
__device__ __forceinline__ XcdBarrier xcd_barrier_post(unsigned* bar, volatile LAS unsigned* st) {
    XcdBarrier b; b.bar = bar; b.x = xb_xcc_id(); b.st = st;
    if (threadIdx.x == 0) (void)xb_add(&bar[XB_XCNT(b.x)], 1u);
    return b;
}
__device__ __forceinline__ void xcd_barrier_complete(unsigned* bar, unsigned x, unsigned& nloc, unsigned& nx) {
    const unsigned G = gridDim.x * gridDim.y * gridDim.z;
    unsigned sum, cnt, mine, sp = 0u;
    for (;;) {
        sum = 0u; cnt = 0u; mine = 0u;
#pragma unroll
        for (unsigned j = 0; j < 16; ++j) { const unsigned c = xb_ld(&bar[XB_XCNT(j)]); sum += c; cnt += (c > 0u) ? 1u : 0u; mine = (j == x) ? c : mine; }
        if (sum == G) break;
        __builtin_amdgcn_s_sleep(1);
        if ((++sp & 255u) == 0u) { if (xb_ld(&bar[XB_TMO])) break; if (sp > XB_SPIN_CAP) { atomicAdd(&bar[XB_TMO], 1u); break; } }
    }
    nloc = mine > 0u ? mine : 1u; nx = cnt > 0u ? cnt : 1u;
}
__device__ __forceinline__ void xcd_barrier(const XcdBarrier& b) {
    asm volatile("s_waitcnt vmcnt(0)" ::: "memory");
    __syncthreads();
    if (threadIdx.x == 0) {
        unsigned* bar = b.bar;
        __builtin_amdgcn_s_waitcnt(0);
        unsigned nloc = b.st[0], nx = b.st[1];
        if (nloc == 0u) { xcd_barrier_complete(bar, b.x, nloc, nx); b.st[0] = nloc; b.st[1] = nx; }
        const unsigned old = xb_add(&bar[XB_XSUB(b.x)], 1u);
        const unsigned gen = old / nloc;
        if (old + 1u == (gen + 1u) * nloc) {
            __builtin_amdgcn_fence(__ATOMIC_RELEASE, "agent");
            asm volatile("s_waitcnt vmcnt(0)" ::: "memory");
            const unsigned og = xb_add(&bar[XB_TOP], 1u);
            const unsigned tg = og / nx;
            if (og + 1u == (tg + 1u) * nx) xb_add(&bar[XB_TOPGEN], 1u);
            else XB_SPIN(xb_ld(&bar[XB_TOPGEN]) == tg, bar);
            __builtin_amdgcn_fence(__ATOMIC_ACQUIRE, "agent");
            xb_add(&bar[XB_XGEN(b.x)], 1u);
            asm volatile("s_waitcnt vmcnt(0)" ::: "memory");
        } else {
            XB_SPIN(xb_ld(&bar[XB_XGEN(b.x)]) == gen, bar);
            __builtin_amdgcn_fence(__ATOMIC_ACQUIRE, "agent");
            asm volatile("s_waitcnt vmcnt(0)" ::: "memory");
        }
    }
    __syncthreads();
}

constexpr int BM = 256, BK = 64, HALF = 128, HTB = HALF * BK * 2, NXCD = 8, WGM = 8;
__device__ __forceinline__ int lds_byte(int r, int c) { const int st = (r >> 4) * 2 + (c >> 5), rr = r & 15, cc = c & 31, ob = rr * 64 + cc * 2; return st * 1024 + (ob ^ (((ob >> 9) & 1) << 5)); }
__device__ __forceinline__ void stage_rc(int b, int& R, int& C) { const int st = b / 1024, sb = b % 1024, swz = sb ^ (((sb >> 9) & 1) << 5); R = (st >> 1) * 16 + swz / 64; C = (st & 1) * 32 + (swz % 64) / 2; }
__device__ __forceinline__ int perm32(int rho) { const int n = rho >> 4, i = rho & 15; return 8 * (i >> 2) + 4 * n + (i & 3); }
struct Unit { int pm, pn; };
struct StaticOrder {
    int nM, nN, nwg, G, c;
    __device__ void init(int M, int N, int G_, int c_) { nM = M / BM; nN = N / BM; nwg = nM * nN; G = G_; c = c_; }
    __device__ bool next(int i, Unit& u) const {
        const long L = (long)i * G + c; if (L >= nwg) return false;
        int wgid = (int)L; { const int q = nwg / NXCD, r = nwg % NXCD, xcd = wgid % NXCD, off = wgid / NXCD; wgid = (xcd < r ? xcd * (q + 1) : r * (q + 1) + (xcd - r) * q) + off; }
        const int nig = WGM * nN, gid = wgid / nig, fm = gid * WGM, gsz = (nM - fm) < WGM ? (nM - fm) : WGM;
        u.pm = fm + ((wgid % nig) % gsz); u.pn = (wgid % nig) / gsz; return true;
    }
};

template <class Epi>
__device__ __forceinline__ void gemm_phase(LAS unsigned char* lds, const bf16_t* A, const bf16_t* Bt, int M, int N, int K, const Epi& E) {
    const int tid = threadIdx.x, wid = __builtin_amdgcn_readfirstlane(tid >> 6), lane = tid & 63, wr = wid >> 2, wc = wid & 3, fr = lane & 15, fq = lane >> 4;
    const int nt = K / BK;
    StaticOrder S; S.init(M, N, (int)gridDim.x, (int)blockIdx.x);
    unsigned voffA[2], voffB[2];
#pragma unroll
    for (int i = 0; i < 2; ++i) { int R, C; stage_rc(tid * 16 + i * 8192, R, C); const int Rb = Epi::PERM ? ((R & ~31) + perm32(R & 31)) : R;
        voffA[i] = (unsigned)(R * K + C) * 2u; voffB[i] = (unsigned)(Rb * K + C) * 2u; }
    const size_t kstep = (size_t)(BK * 2);
    const size_t hstep = (size_t)HALF * K * 2;
    const size_t tstep = 2 * hstep;
    const unsigned ldsw = (unsigned)wid * 1024u;
    const int aoff = lds_byte(wr * 64 + fr, fq * 8), boff = lds_byte(wc * 32 + fr, fq * 8);
#define G_SA(b, h) (((b) * 2 + (h)) * HTB)
#define G_SB(b, h) ((4 + (b) * 2 + (h)) * HTB)
#define G_STAGE(bufoff, gbase, voff) do { _Pragma("unroll") for (int _i = 0; _i < 2; ++_i) \
        __builtin_amdgcn_global_load_lds((const unsigned*)((const char*)(gbase) + (voff)[_i]), (LAS unsigned*)(lds + (bufoff) + ldsw + _i * 8192), 16, 0, 0); } while (0)
#define G_LDA(dst, b, h) do { _Pragma("unroll") for (int m = 0; m < 4; ++m) _Pragma("unroll") for (int k = 0; k < 2; ++k) dst[m][k] = *(const LAS bf16x8*)(lds + G_SA(b, h) + aoff + m * 2048 + k * 1024); } while (0)
#define G_LDB(dst, b, h) do { _Pragma("unroll") for (int n = 0; n < 2; ++n) _Pragma("unroll") for (int k = 0; k < 2; ++k) dst[n][k] = *(const LAS bf16x8*)(lds + G_SB(b, h) + boff + n * 2048 + k * 1024); } while (0)
#define G_MMA(ai, bj, At, Bt_) do { __builtin_amdgcn_s_setprio(1); _Pragma("unroll") for (int m = 0; m < 4; ++m) _Pragma("unroll") for (int n = 0; n < 2; ++n) _Pragma("unroll") for (int k = 0; k < 2; ++k) \
        acc[ai][bj][m][n] = __builtin_amdgcn_mfma_f32_16x16x32_bf16(Bt_[n][k], At[m][k], acc[ai][bj][m][n], 0, 0, 0); __builtin_amdgcn_s_setprio(0); } while (0)
#define G_WAIT_V(n) asm volatile("s_waitcnt vmcnt(" #n ")" ::: "memory")
#define G_WAIT_L(n) asm volatile("s_waitcnt lgkmcnt(" #n ")" ::: "memory")
#define G_BAR __builtin_amdgcn_s_barrier()
#define G_SCHED __builtin_amdgcn_sched_barrier(0)
    Unit cur, nxt; int ui = 0;
    if (!S.next(0, cur)) return;
    f32x4 acc[2][2][4][2];
#pragma unroll
    for (int a = 0; a < 2; ++a)
#pragma unroll
        for (int b = 0; b < 2; ++b)
#pragma unroll
            for (int m = 0; m < 4; ++m)
#pragma unroll
                for (int n = 0; n < 2; ++n) acc[a][b][m][n] = (f32x4){0.f, 0.f, 0.f, 0.f};
    bf16x8 At[4][2], B0[2][2], B1[2][2];
    const char* cA = (const char*)A + (size_t)cur.pm * tstep; const char* cB = (const char*)Bt + (size_t)cur.pn * tstep;
    G_STAGE(G_SB(0, 0), cB, voffB); G_STAGE(G_SA(0, 0), cA, voffA); G_STAGE(G_SB(0, 1), cB + hstep, voffB); G_STAGE(G_SA(0, 1), cA + hstep, voffA);
    if (wr == 1) G_BAR;
    G_WAIT_V(4); G_BAR;
    G_STAGE(G_SB(1, 0), cB + kstep, voffB); G_STAGE(G_SA(1, 0), cA + kstep, voffA); G_STAGE(G_SB(1, 1), cB + hstep + kstep, voffB);
    G_WAIT_V(6); G_BAR;
    for (;;) {
        const bool has_next = S.next(ui + 1, nxt);
        const char* nA = has_next ? (const char*)A + (size_t)nxt.pm * tstep : cA; const char* nB = has_next ? (const char*)Bt + (size_t)nxt.pn * tstep : cB;
        for (int t = 0; t < nt; t += 2) {
            const bool last = (t == nt - 2);
            const char* a1 = cA + (size_t)(t + 1) * kstep;
            const char* a2 = last ? nA : cA + (size_t)(t + 2) * kstep; const char* b2 = last ? nB : cB + (size_t)(t + 2) * kstep;
            const char* a3 = a2 + kstep; const char* b3 = b2 + kstep;
            G_LDB(B0, 0, 0); G_SCHED; G_LDA(At, 0, 0); G_STAGE(G_SA(1, 1), a1 + hstep, voffA);
            G_WAIT_L(8); G_BAR; G_WAIT_L(0); G_MMA(0, 0, At, B0); G_BAR; G_SCHED;
            G_LDB(B1, 0, 1); G_STAGE(G_SB(0, 0), b2, voffB);
            G_BAR; G_WAIT_L(0); G_MMA(0, 1, At, B1); G_BAR;
            G_LDA(At, 0, 1); G_STAGE(G_SA(0, 0), a2, voffA);
            G_BAR; G_WAIT_L(0); G_MMA(1, 0, At, B0); G_BAR; G_SCHED;
            G_STAGE(G_SB(0, 1), b2 + hstep, voffB);
            G_WAIT_V(6); G_BAR; G_MMA(1, 1, At, B1); G_BAR;
            G_LDB(B0, 1, 0); G_SCHED; G_LDA(At, 1, 0); G_STAGE(G_SA(0, 1), a2 + hstep, voffA);
            G_WAIT_L(8); G_BAR; G_WAIT_L(0); G_MMA(0, 0, At, B0); G_BAR; G_SCHED;
            G_LDB(B1, 1, 1); G_STAGE(G_SB(1, 0), b3, voffB);
            G_BAR; G_WAIT_L(0); G_MMA(0, 1, At, B1); G_BAR;
            G_LDA(At, 1, 1); G_STAGE(G_SA(1, 0), a3, voffA);
            G_BAR; G_WAIT_L(0); G_MMA(1, 0, At, B0); G_BAR; G_SCHED;
            G_STAGE(G_SB(1, 1), b3 + hstep, voffB);
            G_WAIT_V(6); G_BAR; G_MMA(1, 1, At, B1); G_BAR;
        }
        if constexpr (!Epi::AFTER_DRAIN) E(acc, cur.pm, cur.pn, wr, wc, fr, fq);
        if (!has_next) break;
#pragma unroll
        for (int a = 0; a < 2; ++a)
#pragma unroll
            for (int b = 0; b < 2; ++b)
#pragma unroll
                for (int m = 0; m < 4; ++m)
#pragma unroll
                    for (int n = 0; n < 2; ++n) acc[a][b][m][n] = (f32x4){0.f, 0.f, 0.f, 0.f};
        cur = nxt; cA = nA; cB = nB; ++ui;
    }
    G_WAIT_V(0);
    if (wr == 0) G_BAR;
    G_BAR;
    if constexpr (Epi::AFTER_DRAIN) E.fused(acc, cur.pm, cur.pn, wr, wc, fr, fq, lds);
#undef G_SA
#undef G_SB
#undef G_STAGE
#undef G_LDA
#undef G_LDB
#undef G_MMA
#undef G_WAIT_V
#undef G_WAIT_L
#undef G_BAR
#undef G_SCHED
}

typedef f32x4 AccT[2][2][4][2];

struct EpiHgrn {
    static constexpr bool PERM = true, AFTER_DRAIN = false;
    bf16_t* q; float* lf; bf16_t* v; bf16_t* sg; const float* lb;
    __device__ __forceinline__ void operator()(const AccT& acc, int pm, int pn, int wr, int wc, int fr, int fq) const {
        const int sec = pn >> 2;
        const int row0 = pm * 256 + wr * 64 + fr, cs0 = (pn & 3) * 256 + wc * 32 + 8 * fq;
        f32x4 l0[2], l1[2];
        if (sec == 1) {
#pragma unroll
            for (int bj = 0; bj < 2; ++bj) { l0[bj] = *(const f32x4*)(lb + cs0 + bj * 128); l1[bj] = *(const f32x4*)(lb + cs0 + bj * 128 + 4); }
        }
#pragma unroll
        for (int ai = 0; ai < 2; ++ai)
#pragma unroll
            for (int m = 0; m < 4; ++m) {
                const size_t ro = (size_t)(row0 + ai * 128 + m * 16) * DM;
#pragma unroll
                for (int bj = 0; bj < 2; ++bj) {
                    f32x4 v0 = acc[ai][bj][m][0], v1 = acc[ai][bj][m][1];
                    const size_t o = ro + cs0 + bj * 128;
                    if (sec == 1) {
#pragma unroll
                        for (int j = 0; j < 4; ++j) {
                            v0[j] = l0[bj][j] + (1.0f - l0[bj][j]) * sigmoidf_(v0[j]);
                            v1[j] = l1[bj][j] + (1.0f - l1[bj][j]) * sigmoidf_(v1[j]);
                        }
                        *(f32x4*)(lf + o) = v0; *(f32x4*)(lf + o + 4) = v1;
                    } else if (sec == 2) {
                        *(u32x4*)(v + o) = pack8(v0, v1);
                    } else {
#pragma unroll
                        for (int j = 0; j < 4; ++j) { v0[j] = siluf_(v0[j]); v1[j] = siluf_(v1[j]); }
                        *(u32x4*)((sec == 0 ? q : sg) + o) = pack8(v0, v1);
                    }
                }
            }
    }
};

struct EpiMoba {
    static constexpr bool PERM = true, AFTER_DRAIN = false;
    bf16_t *q, *k, *v, *sg; const float* rope; float* kmean;
    __device__ __forceinline__ void operator()(const AccT& acc, int pm, int pn, int wr, int wc, int fr, int fq) const {
        const int sec = pn >> 2;
        const int row0 = pm * 256 + wr * 64 + fr, cs0 = (pn & 3) * 256 + wc * 32 + 8 * fq;
        if (sec < 2) {
            const int d0 = 16 * wc + 4 * fq;
            bf16_t* dst = sec == 0 ? q : k;
            const float sc = sec == 0 ? 0.08838834764831845f * 1.4426950408889634f : 1.0f;
            f32x4 ks1[2], ks2[2];
#pragma unroll
            for (int bj = 0; bj < 2; ++bj) { ks1[bj] = (f32x4){0.f, 0.f, 0.f, 0.f}; ks2[bj] = (f32x4){0.f, 0.f, 0.f, 0.f}; }
            const int odd = fq & 1;
#pragma unroll
            for (int ai = 0; ai < 2; ++ai)
#pragma unroll
                for (int m = 0; m < 4; ++m) {
                    const int row = row0 + ai * 128 + m * 16; const int pos = row & (SEQ - 1);
                    const f32x4 cs = *(const f32x4*)(rope + pos * 64 + d0), sn = *(const f32x4*)(rope + SEQ * 64 + pos * 64 + d0);
#pragma unroll
                    for (int bj = 0; bj < 2; ++bj) {
                        const int head = (pn & 3) * 2 + bj;
                        const f32x4 v0 = acc[ai][bj][m][0], v1 = acc[ai][bj][m][1];
                        const f32x4 t1 = (f32x4){v0[0], v0[2], v1[0], v1[2]}, t2 = (f32x4){v0[1], v0[3], v1[1], v1[3]};
                        const f32x4 o1 = (t1 * cs - t2 * sn) * sc, o2 = (t2 * cs + t1 * sn) * sc;
                        if (sec == 1) { ks1[bj] += o1; ks2[bj] += o2; }
                        const u32x2 pa = pack4(o1), pb = pack4(o2);
                        const auto sx = __builtin_amdgcn_permlane16_swap(pa.x, pb.x, false, false);
                        const auto sy = __builtin_amdgcn_permlane16_swap(pa.y, pb.y, false, false);
                        *(u32x4*)(dst + (size_t)row * DM + head * 128 + (d0 - 4 * odd) + 64 * odd) = (u32x4){sx[0], sy[0], sx[1], sy[1]};
                    }
                }
            if (sec == 1) {
#pragma unroll
                for (int bj = 0; bj < 2; ++bj) {
                    const int head = (pn & 3) * 2 + bj;
#pragma unroll
                    for (int j = 0; j < 4; ++j) {
                        float a = ks1[bj][j], b = ks2[bj][j];
#pragma unroll
                        for (int o = 1; o < 16; o <<= 1) { a += __shfl_xor(a, o); b += __shfl_xor(b, o); }
                        ks1[bj][j] = a; ks2[bj][j] = b;
                    }
                    if (fr == 0) {
                        float* kp = kmean + (size_t)(((pm >> 3) * 8 + head) * 8 + (pm & 7)) * 128 + d0;
#pragma unroll
                        for (int j = 0; j < 4; ++j) { atomicAdd(kp + j, ks1[bj][j] * (1.0f / 256.0f)); atomicAdd(kp + 64 + j, ks2[bj][j] * (1.0f / 256.0f)); }
                    }
                }
            }
        } else if (sec == 2) {
#pragma unroll
            for (int ai = 0; ai < 2; ++ai)
#pragma unroll
                for (int m = 0; m < 4; ++m) {
                    const int row = row0 + ai * 128 + m * 16; const int bb = row >> 11, ss = row & (SEQ - 1);
#pragma unroll
                    for (int bj = 0; bj < 2; ++bj) {
                        const f32x4 v0 = acc[ai][bj][m][0], v1 = acc[ai][bj][m][1];
                        const int head = (pn & 3) * 2 + bj;
                        bf16_t* vp = v + ((size_t)((bb * 8 + head) * 128 + wc * 32 + 8 * fq)) * SEQ + ss;
                        const u32x4 pw = pack8(v0, v1);
                        vp[0] = (bf16_t)(pw.x & 0xffffu); vp[SEQ] = (bf16_t)(pw.x >> 16); vp[2 * SEQ] = (bf16_t)(pw.y & 0xffffu); vp[3 * SEQ] = (bf16_t)(pw.y >> 16);
                        vp[4 * SEQ] = (bf16_t)(pw.z & 0xffffu); vp[5 * SEQ] = (bf16_t)(pw.z >> 16); vp[6 * SEQ] = (bf16_t)(pw.w & 0xffffu); vp[7 * SEQ] = (bf16_t)(pw.w >> 16);
                    }
                }
        } else {
#pragma unroll
            for (int ai = 0; ai < 2; ++ai)
#pragma unroll
                for (int m = 0; m < 4; ++m) {
                    const size_t ro = (size_t)(row0 + ai * 128 + m * 16) * DM;
#pragma unroll
                    for (int bj = 0; bj < 2; ++bj) {
                        f32x4 v0 = acc[ai][bj][m][0], v1 = acc[ai][bj][m][1];
                        const size_t o = ro + cs0 + bj * 128;
#pragma unroll
                        for (int j = 0; j < 4; ++j) { v0[j] = siluf_(v0[j]); v1[j] = siluf_(v1[j]); }
                        *(u32x4*)(sg + o) = pack8(v0, v1);
                    }
                }
        }
    }
};

struct EpiS5 {
    static constexpr bool PERM = true, AFTER_DRAIN = false;
    bf16_t *u, *sg;
    __device__ __forceinline__ void operator()(const AccT& acc, int pm, int pn, int wr, int wc, int fr, int fq) const {
        const int sec = pn >> 2;
        const int row0 = pm * 256 + wr * 64 + fr, cs0 = (pn & 3) * 256 + wc * 32 + 8 * fq;
#pragma unroll
        for (int ai = 0; ai < 2; ++ai)
#pragma unroll
            for (int m = 0; m < 4; ++m) {
                const size_t ro = (size_t)(row0 + ai * 128 + m * 16) * DM;
#pragma unroll
                for (int bj = 0; bj < 2; ++bj) {
                    f32x4 v0 = acc[ai][bj][m][0], v1 = acc[ai][bj][m][1];
                    const size_t o = ro + cs0 + bj * 128;
                    if (sec == 1) {
#pragma unroll
                        for (int j = 0; j < 4; ++j) { v0[j] = siluf_(v0[j]); v1[j] = siluf_(v1[j]); }
                        *(u32x4*)(sg + o) = pack8(v0, v1);
                    } else {
                        const int row = row0 + ai * 128 + m * 16, cc = cs0 + bj * 128;
                        *(u32x4*)(u + ((size_t)((cc >> 4) * 16 + (row >> 11)) * SEQ + (row & (SEQ - 1))) * 16 + (cc & 8)) = pack8(v0, v1);
                    }
                }
            }
    }
};

struct EpiGlu {
    static constexpr bool PERM = true, AFTER_DRAIN = false;
    const bf16_t *y, *sg; const float* bias; bf16_t* o;
    __device__ __forceinline__ void operator()(const AccT& acc, int pm, int pn, int wr, int wc, int fr, int fq) const {
        const int row0 = pm * 256 + wr * 64 + fr, cs0 = pn * 256 + wc * 32 + 8 * fq;
        f32x4 b0[2], b1[2];
#pragma unroll
        for (int bj = 0; bj < 2; ++bj) { b0[bj] = *(const f32x4*)(bias + cs0 + bj * 128); b1[bj] = *(const f32x4*)(bias + cs0 + bj * 128 + 4); }
#pragma unroll
        for (int ai = 0; ai < 2; ++ai)
#pragma unroll
            for (int m = 0; m < 4; ++m) {
                const size_t ro = (size_t)(row0 + ai * 128 + m * 16) * DM;
#pragma unroll
                for (int bj = 0; bj < 2; ++bj) {
                    const size_t off = ro + cs0 + bj * 128;
                    const f32x4 z0 = acc[ai][bj][m][0] + b0[bj], z1 = acc[ai][bj][m][1] + b1[bj];
                    const u32x4 yv = *(const u32x4*)(y + off), gv = *(const u32x4*)(sg + off);
                    f32x4 r0, r1;
                    r0[0] = blo(yv.x) * sigmoidf_(z0[0]) * blo(gv.x); r0[1] = bhi(yv.x) * sigmoidf_(z0[1]) * bhi(gv.x);
                    r0[2] = blo(yv.y) * sigmoidf_(z0[2]) * blo(gv.y); r0[3] = bhi(yv.y) * sigmoidf_(z0[3]) * bhi(gv.y);
                    r1[0] = blo(yv.z) * sigmoidf_(z1[0]) * blo(gv.z); r1[1] = bhi(yv.z) * sigmoidf_(z1[1]) * bhi(gv.z);
                    r1[2] = blo(yv.w) * sigmoidf_(z1[2]) * blo(gv.w); r1[3] = bhi(yv.w) * sigmoidf_(z1[3]) * bhi(gv.w);
                    *(u32x4*)(o + off) = pack8(r0, r1);
                }
            }
    }
};

struct EpiOut {
    static constexpr bool PERM = false, AFTER_DRAIN = false;
    const float* res; float* t; int use_acc;
    __device__ __forceinline__ void operator()(const AccT& acc, int pm, int pn, int wr, int wc, int fr, int fq) const {
        const int row0 = pm * 256 + wr * 64 + fr, col0 = pn * 256 + wc * 32 + 4 * fq;
#pragma unroll
        for (int ai = 0; ai < 2; ++ai)
#pragma unroll
            for (int m = 0; m < 4; ++m) {
                const size_t ro = (size_t)(row0 + ai * 128 + m * 16) * DM + col0;
#pragma unroll
                for (int bj = 0; bj < 2; ++bj)
#pragma unroll
                    for (int n = 0; n < 2; ++n) {
                        const size_t off = ro + bj * 128 + n * 16;
                        const f32x4 r = *(const f32x4*)(res + off);
                        f32x4 a = acc[ai][bj][m][n]; if (!use_acc) a = (f32x4){0.f, 0.f, 0.f, 0.f};
                        *(f32x4*)(t + off) = r * ALPHA + a;
                    }
            }
    }
};


struct EpiOutLn {
    static constexpr bool PERM = false, AFTER_DRAIN = true;
    const float* res; float* dst; bf16_t* xb; bf16_t* xlo; const float* g; const float* bb; float* X; unsigned* cnt; int pm_off, use_acc, last, split_in;
    __device__ __forceinline__ void operator()(const AccT&, int, int, int, int, int, int) const {}
    __device__ __forceinline__ void fused(AccT& acc, int pm, int pn, int wr, int wc, int fr, int fq, LAS unsigned char* lds) const {
        const int tid = threadIdx.x;
        LAS float* part = (LAS float*)(lds + 131072);
        LAS float* stat = (LAS float*)(lds + 131072 + 8192);
        const int gpm = pm_off + pm;
        const int row0 = gpm * 256 + wr * 64 + fr, col0 = pn * 256 + wc * 32 + 4 * fq;
#pragma unroll
        for (int ai = 0; ai < 2; ++ai)
#pragma unroll
            for (int m = 0; m < 4; ++m) {
                const size_t ro = (size_t)(row0 + ai * 128 + m * 16) * DM + col0;
                float s1 = 0.f, s2 = 0.f;
#pragma unroll
                for (int bj = 0; bj < 2; ++bj) {
                    f32x4 rr[2];
                    if (split_in) {
                        const size_t os = ro - 4 * fq + 4 * (fq & 2) + bj * 128 + (fq & 1) * 16;
                        const u32x4 hi = *(const u32x4*)(xb + os), lo = *(const u32x4*)(xlo + os);
                        const f32x4 q0 = (f32x4){blo(hi.x) + blo(lo.x), bhi(hi.x) + bhi(lo.x), blo(hi.y) + blo(lo.y), bhi(hi.y) + bhi(lo.y)};
                        const f32x4 q1 = (f32x4){blo(hi.z) + blo(lo.z), bhi(hi.z) + bhi(lo.z), blo(hi.w) + blo(lo.w), bhi(hi.w) + bhi(lo.w)};
#pragma unroll
                        for (int i = 0; i < 4; ++i) {
                            const auto sw = __builtin_amdgcn_permlane16_swap(__float_as_uint(q0[i]), __float_as_uint(q1[i]), false, false);
                            rr[0][i] = __uint_as_float(sw[0]); rr[1][i] = __uint_as_float(sw[1]);
                        }
                    } else {
                        rr[0] = *(const f32x4*)(res + ro + bj * 128); rr[1] = *(const f32x4*)(res + ro + bj * 128 + 16);
                    }
#pragma unroll
                    for (int n = 0; n < 2; ++n) {
                        f32x4 t = rr[n] * ALPHA; if (use_acc) t += acc[ai][bj][m][n];
                        acc[ai][bj][m][n] = t;
                        s1 += (t[0] + t[1]) + (t[2] + t[3]); s2 += (t[0] * t[0] + t[1] * t[1]) + (t[2] * t[2] + t[3] * t[3]);
                    }
                }
                s1 += __shfl_xor(s1, 16); s1 += __shfl_xor(s1, 32); s2 += __shfl_xor(s2, 16); s2 += __shfl_xor(s2, 32);
                if (fq == 0) { const int rl = ai * 128 + wr * 64 + m * 16 + fr; part[(rl * 4 + wc) * 2] = s1; part[(rl * 4 + wc) * 2 + 1] = s2; }
            }
        __syncthreads();
        if (tid < 256) {
            const float S = (part[(tid * 4 + 0) * 2] + part[(tid * 4 + 1) * 2]) + (part[(tid * 4 + 2) * 2] + part[(tid * 4 + 3) * 2]);
            const float Q = (part[(tid * 4 + 0) * 2 + 1] + part[(tid * 4 + 1) * 2 + 1]) + (part[(tid * 4 + 2) * 2 + 1] + part[(tid * 4 + 3) * 2 + 1]);
            float* xp = X + ((size_t)(gpm * 4 + pn) * 256 + tid) * 2;
            __hip_atomic_store(xp, S, __ATOMIC_RELAXED, __HIP_MEMORY_SCOPE_AGENT); __hip_atomic_store(xp + 1, Q, __ATOMIC_RELAXED, __HIP_MEMORY_SCOPE_AGENT);
        }
        asm volatile("s_waitcnt vmcnt(0)" ::: "memory");
        __syncthreads();
        if (tid == 0) {
            __hip_atomic_fetch_add(cnt + gpm, 1u, __ATOMIC_RELAXED, __HIP_MEMORY_SCOPE_AGENT);
            unsigned it = 0;
            while (__hip_atomic_load(cnt + gpm, __ATOMIC_RELAXED, __HIP_MEMORY_SCOPE_AGENT) < 4u && ++it < (1u << 22)) __builtin_amdgcn_s_sleep(1);
        }
        __syncthreads();
        if (tid < 256) {
            float S = 0.f, Q = 0.f;
#pragma unroll
            for (int p2 = 0; p2 < 4; ++p2) { const float* xp = X + ((size_t)(gpm * 4 + p2) * 256 + tid) * 2;
                S += __hip_atomic_load(xp, __ATOMIC_RELAXED, __HIP_MEMORY_SCOPE_AGENT); Q += __hip_atomic_load(xp + 1, __ATOMIC_RELAXED, __HIP_MEMORY_SCOPE_AGENT); }
            const float mean = S * (1.0f / 1024.0f); const float var = fmaxf(Q * (1.0f / 1024.0f) - mean * mean, 0.f);
            stat[tid * 2] = mean; stat[tid * 2 + 1] = 1.0f / sqrtf(var + 1e-5f);
        }
        __syncthreads();
        f32x4 gq[2][2], bq4[2][2];
#pragma unroll
        for (int bj = 0; bj < 2; ++bj)
#pragma unroll
            for (int n = 0; n < 2; ++n) { gq[bj][n] = *(const f32x4*)(g + col0 + bj * 128 + n * 16); bq4[bj][n] = *(const f32x4*)(bb + col0 + bj * 128 + n * 16); }
#pragma unroll
        for (int ai = 0; ai < 2; ++ai)
#pragma unroll
            for (int m = 0; m < 4; ++m) {
                const int rl = ai * 128 + wr * 64 + m * 16 + fr;
                const float mean = stat[rl * 2], rstd = stat[rl * 2 + 1];
                const size_t ro = (size_t)(row0 + ai * 128 + m * 16) * DM + col0;
#pragma unroll
                for (int bj = 0; bj < 2; ++bj) {
                    u32x2 yb[2], yl[2];
#pragma unroll
                    for (int n = 0; n < 2; ++n) {
                        const f32x4 y = (acc[ai][bj][m][n] - mean) * rstd * gq[bj][n] + bq4[bj][n];
                        if (last) *(f32x4*)(dst + ro + bj * 128 + n * 16) = y;
                        yb[n] = pack4(y);
                        const f32x4 yr = (f32x4){y[0] - blo(yb[n].x), y[1] - bhi(yb[n].x), y[2] - blo(yb[n].y), y[3] - bhi(yb[n].y)};
                        yl[n] = pack4(yr);
                    }
                    if (!last) {
                        const size_t os = ro - 4 * fq + 4 * (fq & 2) + bj * 128 + (fq & 1) * 16;
                        const auto sx = __builtin_amdgcn_permlane16_swap(yb[0].x, yb[1].x, false, false);
                        const auto sy = __builtin_amdgcn_permlane16_swap(yb[0].y, yb[1].y, false, false);
                        *(u32x4*)(xb + os) = (u32x4){sx[0], sy[0], sx[1], sy[1]};
                        const auto lx = __builtin_amdgcn_permlane16_swap(yl[0].x, yl[1].x, false, false);
                        const auto ly = __builtin_amdgcn_permlane16_swap(yl[0].y, yl[1].y, false, false);
                        *(u32x4*)(xlo + os) = (u32x4){lx[0], ly[0], lx[1], ly[1]};
                    }
                }
            }
        __syncthreads();
    }
};

__device__ __forceinline__ void transpose_w(const float* w, int N, bf16_t* wt, int moba, int gw, int nw, int lane) {
    const int nbn = N >> 3, nitems = nbn * 16;
    const int nl = lane & 7, kl = lane >> 3;
    for (int it = gw; it < nitems; it += nw) {
        const int nb = it % nbn, kb = it / nbn;
        const int n = nb * 8 + nl, k0 = kb * 64 + kl * 8;
        float f[8];
#pragma unroll
        for (int i = 0; i < 8; ++i) f[i] = w[(size_t)(k0 + i) * N + n];
        int np = n;
        if (moba && n < 2048) { const int d = n & 127; np = (n & ~127) + ((d & 63) << 1) + (d >> 6); }
        u32x4 o; o.x = pk(f[0], f[1]); o.y = pk(f[2], f[3]); o.z = pk(f[4], f[5]); o.w = pk(f[6], f[7]);
        *(u32x4*)(wt + (size_t)np * 1024 + k0) = o;
    }
}

__device__ __forceinline__ void s5_setup(const P& p, int g, LAS unsigned char* lds) {
    LAS float* apr = (LAS float*)lds;
    LAS float* api = apr + 17 * 64;
    LAS float* bbr = api + 17 * 64;
    LAS float* bbi = bbr + 1024;
    LAS float* ccr = bbi + 1024;
    LAS float* cci = ccr + 1024;
    LAS float* Kt = cci + 1024;
    const int tid = threadIdx.x;
    __syncthreads();
    if (tid < 64) {
        const int pp = tid;
        const float dt = expf(p.log_dt[g]);
        const float ar = p.a_re[g * 64 + pp], ai = p.a_im[g * 64 + pp];
        const float mag = expf(dt * ar); const float th = dt * ai;
        const float abr = mag * cosf(th), abi = mag * sinf(th);
        const float nr = abr - 1.0f, ni = abi, den = ar * ar + ai * ai;
        const float zr = (nr * ar + ni * ai) / den, zi = (ni * ar - nr * ai) / den;
        for (int h = 0; h < 16; ++h) {
            const float br = p.b_re[(size_t)(g * 64 + pp) * 16 + h], bi = p.b_im[(size_t)(g * 64 + pp) * 16 + h];
            bbr[pp * 16 + h] = zr * br - zi * bi; bbi[pp * 16 + h] = zr * bi + zi * br;
        }
        float pr = 1.0f, pi = 0.0f;
        for (int t = 0; t <= 16; ++t) { apr[t * 64 + pp] = pr; api[t * 64 + pp] = pi; const float nr2 = pr * abr - pi * abi, ni2 = pr * abi + pi * abr; pr = nr2; pi = ni2; }
        p.a16[(g * 64 + pp) * 2] = apr[16 * 64 + pp]; p.a16[(g * 64 + pp) * 2 + 1] = api[16 * 64 + pp];
    }
    for (int i = tid; i < 1024; i += 512) { ccr[i] = p.c_re[(size_t)g * 1024 + i]; cci[i] = p.c_im[(size_t)g * 1024 + i]; }
    __syncthreads();
    for (int e = tid; e < 4096; e += 512) {
        const int tau = e >> 8, hp = (e >> 4) & 15, h = e & 15;
        float s = 0.f;
        for (int pp = 0; pp < 64; ++pp) {
            const float cr = ccr[hp * 64 + pp], ci = cci[hp * 64 + pp], pr = apr[tau * 64 + pp], pi = api[tau * 64 + pp];
            const float car = cr * pr - ci * pi, cai = cr * pi + ci * pr;
            s += car * bbr[pp * 16 + h] - cai * bbi[pp * 16 + h];
        }
        Kt[e] = s;
    }
    __syncthreads();
    bf16_t* W1 = p.s5w1 + (size_t)g * 32768; bf16_t* T = p.s5t + (size_t)g * 65536; bf16_t* W2 = p.s5w2 + (size_t)g * 32768;
    for (int e = tid; e < 32768; e += 512) {
        const int n = e >> 8, kk = e & 255, j = kk >> 4, h = kk & 15, pp = n & 63;
        const float pr = apr[(15 - j) * 64 + pp], pi = api[(15 - j) * 64 + pp], br = bbr[pp * 16 + h], bi = bbi[pp * 16 + h];
        W1[e] = f2bf(n < 64 ? pr * br - pi * bi : pr * bi + pi * br);
    }
    for (int e = tid; e < 65536; e += 512) {
        const int n = e >> 8, kk = e & 255, j = n >> 4, hp = n & 15, j2 = kk >> 4, h = kk & 15;
        T[e] = f2bf(j2 <= j ? Kt[(j - j2) * 256 + hp * 16 + h] : 0.0f);
    }
    for (int e = tid; e < 32768; e += 512) {
        const int n = e >> 7, kk = e & 127, j = n >> 4, hp = n & 15, pp = kk & 63;
        const float pr = apr[(j + 1) * 64 + pp], pi = api[(j + 1) * 64 + pp], cr = ccr[hp * 64 + pp], ci = cci[hp * 64 + pp];
        W2[e] = f2bf(kk < 64 ? cr * pr - ci * pi : -(cr * pi + ci * pr));
    }
    __syncthreads();
}

__device__ __forceinline__ void prologue(const P& p, LAS unsigned char* lds) {
    const int tid = threadIdx.x, lane = tid & 63;
    const int gw = blockIdx.x * 8 + (tid >> 6), nw = gridDim.x * 8;
    const int gt = blockIdx.x * 512 + tid, ntot = gridDim.x * 512;
    for (int c = gt; c < 1024; c += ntot) {
        const float a0 = p.lbl[c], a1 = p.lbl[1024 + c], a2 = p.lbl[2048 + c], a3 = p.lbl[3072 + c];
        const float mx = fmaxf(fmaxf(a0, a1), fmaxf(a2, a3));
        const float e0 = expf(a0 - mx), e1 = expf(a1 - mx), e2 = expf(a2 - mx), e3 = expf(a3 - mx);
        const float inv = 1.0f / (e0 + e1 + e2 + e3);
        p.lb[c] = 0.0f; p.lb[1024 + c] = e1 * inv; p.lb[2048 + c] = (e1 + e2) * inv; p.lb[3072 + c] = (e1 + e2 + e3) * inv;
    }
    for (int e = gt; e < 16 * 8 * 8 * 128; e += ntot) p.kmean[e] = 0.0f;
    for (int e = gt; e < 512; e += ntot) p.lncnt[e] = 0u;
    for (size_t e = (size_t)gt; e < (size_t)NTOK * DM / 8; e += ntot) {
        const f32x4 a = *(const f32x4*)(p.x + e * 8), b = *(const f32x4*)(p.x + e * 8 + 4);
        *(u32x4*)(p.xb + e * 8) = pack8(a, b);
    }
    transpose_w(p.w_in[0], 4096, p.wt_in[0], 0, gw, nw, lane);
    transpose_w(p.w_out[0], 1024, p.wt_out[0], 0, gw, nw, lane);
}
__device__ __forceinline__ void prologue_b(const P& p, int wg, int nwg, LAS unsigned char* lds) {
    const int tid = threadIdx.x, lane = tid & 63;
    const int gw = wg * 8 + (tid >> 6), nw = nwg * 8;
    const int gt = wg * 512 + tid, ntot = nwg * 512;
    for (int g = wg; g < 64; g += nwg) s5_setup(p, g, lds);
    for (int e = gt; e < SEQ * 64; e += ntot) {
        const int pos = e >> 6, i = e & 63;
        const float inv_freq = 1.0f / powf(10000.0f, (float)(2 * i) / 128.0f);
        const float ang = (float)pos * inv_freq;
        p.rope[e] = cosf(ang); p.rope[SEQ * 64 + e] = sinf(ang);
    }
    transpose_w(p.w_in[1], 4096, p.wt_in[1], 1, gw, nw, lane);
    transpose_w(p.w_in[2], 2048, p.wt_in[2], 0, gw, nw, lane);
    transpose_w(p.w_in[3], 4096, p.wt_in[3], 0, gw, nw, lane);
    for (int l = 1; l < 4; ++l) transpose_w(p.w_out[l], 1024, p.wt_out[l], 0, gw, nw, lane);
    transpose_w(p.w_glu, 1024, p.wt_glu, 0, gw, nw, lane);
}

__device__ __forceinline__ void ln_phase(const P& p, int layer) {
    const int tid = threadIdx.x, lane = tid & 63;
    const int gw = blockIdx.x * 8 + (tid >> 6), nw = gridDim.x * 8;
    const float* g = p.ln_g[layer]; const float* bb = p.ln_b[layer];
    f32x4 gv[4], bv[4];
#pragma unroll
    for (int r = 0; r < 4; ++r) { gv[r] = *(const f32x4*)(g + r * 256 + lane * 4); bv[r] = *(const f32x4*)(bb + r * 256 + lane * 4); }
    const bool last = layer == 3;
    float* dst = last ? p.out : p.xf;
    for (int row = gw; row < NTOK; row += nw) {
        const float* src = p.xf + (size_t)row * DM;
        f32x4 v[4];
#pragma unroll
        for (int r = 0; r < 4; ++r) v[r] = *(const f32x4*)(src + r * 256 + lane * 4);
        float s = 0.f;
#pragma unroll
        for (int r = 0; r < 4; ++r) s += v[r][0] + v[r][1] + v[r][2] + v[r][3];
#pragma unroll
        for (int o = 32; o >= 1; o >>= 1) s += __shfl_xor(s, o);
        const float mu = s * (1.0f / 1024.0f);
        float q = 0.f;
#pragma unroll
        for (int r = 0; r < 4; ++r) { v[r] = v[r] - mu; q += v[r][0] * v[r][0] + v[r][1] * v[r][1] + v[r][2] * v[r][2] + v[r][3] * v[r][3]; }
#pragma unroll
        for (int o = 32; o >= 1; o >>= 1) q += __shfl_xor(q, o);
        const float rstd = 1.0f / sqrtf(q * (1.0f / 1024.0f) + 1e-5f);
#pragma unroll
        for (int r = 0; r < 4; ++r) {
            const f32x4 y = v[r] * rstd * gv[r] + bv[r];
            *(f32x4*)(dst + (size_t)row * DM + r * 256 + lane * 4) = y;
            if (!last) *(u32x2*)(p.xb + (size_t)row * DM + r * 256 + lane * 4) = pack4(y);
        }
    }
}

__device__ __forceinline__ void hgrn_scan(const P& p, int layer, LAS unsigned char* lds) {
    const int tid = threadIdx.x, w = tid >> 6, lane = tid & 63, lr = lane & 15, lq = lane >> 4;
    LAS bf16_t* qd = (LAS bf16_t*)(lds);
    LAS bf16_t* kd = (LAS bf16_t*)(lds + 17408);
    LAS bf16_t* keT = (LAS bf16_t*)(lds + 34816);
    LAS bf16_t* vT = (LAS bf16_t*)(lds + 53248);
    LAS bf16_t* Pm = (LAS bf16_t*)(lds + 71680);
    LAS bf16_t* stT = (LAS bf16_t*)(lds + 80896);
    LAS float* qsum = (LAS float*)(lds + 115712);
    LAS float* dl = (LAS float*)(lds + 117760);
    LAS float* em = (LAS float*)(lds + 118272);
    LAS float* osm = (LAS float*)(lds + 118784);
    const float* fb = p.out;
    const bf16_t* qg = p.s[0]; const bf16_t* vg = p.s[2]; const bf16_t* sgg = p.s[3]; bf16_t* ab = p.ab;
    const int ek = tid & 127, etq = tid >> 7;
    const int vs = tid >> 3, vv0 = (tid & 7) * 16;
    for (int item = blockIdx.x; item < 128; item += gridDim.x) {
        const int b = item >> 3, h = item & 7;
        f32x4 st[8];
#pragma unroll
        for (int i = 0; i < 8; ++i) st[i] = (f32x4){0.f, 0.f, 0.f, 0.f};
        f32x4 ngv[4];
#pragma unroll
        for (int i = 0; i < 4; ++i) ngv[i] = *(const f32x4*)(p.norm_g[layer] + h * 128 + vv0 + i * 4);
        float fv[16]; bf16_t qv[16]; u32x4 vr0, vr1, gr0, gr1;
#define HG_LOAD(c_) do { const size_t _r0 = (size_t)b * SEQ + (c_) * 64; \
            _Pragma("unroll") for (int i = 0; i < 16; ++i) { const size_t o = (_r0 + etq * 16 + i) * DM + h * 128 + ek; fv[i] = fb[o]; qv[i] = qg[o]; } \
            const size_t _vo = (_r0 + vs) * DM + h * 128 + vv0; \
            vr0 = *(const u32x4*)(vg + _vo); vr1 = *(const u32x4*)(vg + _vo + 8); gr0 = *(const u32x4*)(sgg + _vo); gr1 = *(const u32x4*)(sgg + _vo + 8); } while (0)
        HG_LOAD(0);
        for (int c = 0; c < 32; ++c) {
            const size_t vo = ((size_t)b * SEQ + c * 64 + vs) * DM + h * 128 + vv0;
            float cp[16];
            {
                float run = 1.0f;
#pragma unroll
                for (int i = 0; i < 16; ++i) { run *= fv[i]; cp[i] = run; }
                qsum[etq * 128 + ek] = run;
            }
            __syncthreads();
            {
                const float q0 = qsum[ek], q1 = qsum[128 + ek], q2 = qsum[256 + ek], q3 = qsum[384 + ek];
                const float pre = etq == 0 ? 1.0f : (etq == 1 ? q0 : (etq == 2 ? q0 * q1 : q0 * q1 * q2));
                const float mref = q0 * q1, blast = mref * (q2 * q3);
                const float invm = 1.0f / mref;
                unsigned kev[8];
#pragma unroll
                for (int i = 0; i < 16; i += 2) {
                    float ke2[2];
#pragma unroll
                    for (int u = 0; u < 2; ++u) {
                        const float e = pre * cp[i + u];
                        const float inv = __builtin_amdgcn_rcpf(e);
                        const float kf = 1.0f - fv[i + u];
                        const int t = etq * 16 + i + u;
                        qd[t * 136 + ek] = f2bf(bf2f(qv[i + u]) * (e * invm));
                        kd[t * 136 + ek] = f2bf(kf * (mref * inv));
                        ke2[u] = kf * (blast * inv);
                    }
                    kev[i >> 1] = pk(ke2[0], ke2[1]);
                }
                *(LAS u32x4*)(keT + ek * 72 + etq * 16) = (u32x4){kev[0], kev[1], kev[2], kev[3]};
                *(LAS u32x4*)(keT + ek * 72 + etq * 16 + 8) = (u32x4){kev[4], kev[5], kev[6], kev[7]};
                if (etq == 0) { dl[ek] = blast; em[ek] = mref; }
                const unsigned vw[8] = {vr0.x, vr0.y, vr0.z, vr0.w, vr1.x, vr1.y, vr1.z, vr1.w};
#pragma unroll
                for (int e = 0; e < 8; ++e) { vT[(vv0 + 2 * e) * 72 + vs] = (bf16_t)(vw[e] & 0xffffu); vT[(vv0 + 2 * e + 1) * 72 + vs] = (bf16_t)(vw[e] >> 16); }
            }
            const u32x4 gc0 = gr0, gc1 = gr1;
            if (c + 1 < 32) HG_LOAD(c + 1);
            __syncthreads();
            {
                const f32x4 e4 = *(const LAS f32x4*)(em + w * 16 + 4 * lq);
#pragma unroll
                for (int vt = 0; vt < 8; ++vt) *(LAS u32x2*)(stT + (vt * 16 + lr) * 136 + w * 16 + 4 * lq) = pack4(st[vt] * e4);
            }
            {
                const int stile = w >> 1;
#pragma unroll
                for (int t2 = 0; t2 < 2; ++t2) {
                    const int ttile = (w & 1) * 2 + t2;
                    f32x4 a = (f32x4){0.f, 0.f, 0.f, 0.f};
                    if (stile <= ttile) {
#pragma unroll
                        for (int ks = 0; ks < 4; ++ks) {
                            const bf16x8 A = *(const LAS bf16x8*)(kd + (stile * 16 + lr) * 136 + ks * 32 + lq * 8);
                            const bf16x8 B = *(const LAS bf16x8*)(qd + (ttile * 16 + lr) * 136 + ks * 32 + lq * 8);
                            a = mfma16(A, B, a);
                        }
#pragma unroll
                        for (int i = 0; i < 4; ++i) if (stile * 16 + 4 * lq + i > ttile * 16 + lr) a[i] = 0.f;
                    }
                    *(LAS u32x2*)(Pm + (ttile * 16 + lr) * 72 + stile * 16 + 4 * lq) = pack4(a);
                }
            }
            __syncthreads();
            {
                bf16x8 av[2], as_[4];
#pragma unroll
                for (int ks = 0; ks < 2; ++ks) av[ks] = *(const LAS bf16x8*)(vT + (w * 16 + lr) * 72 + ks * 32 + lq * 8);
#pragma unroll
                for (int ks = 0; ks < 4; ++ks) as_[ks] = *(const LAS bf16x8*)(stT + (w * 16 + lr) * 136 + ks * 32 + lq * 8);
#pragma unroll
                for (int tt = 0; tt < 4; ++tt) {
                    f32x4 a = (f32x4){0.f, 0.f, 0.f, 0.f};
#pragma unroll
                    for (int ks = 0; ks < 2; ++ks) a = mfma16(av[ks], *(const LAS bf16x8*)(Pm + (tt * 16 + lr) * 72 + ks * 32 + lq * 8), a);
#pragma unroll
                    for (int ks = 0; ks < 4; ++ks) a = mfma16(as_[ks], *(const LAS bf16x8*)(qd + (tt * 16 + lr) * 136 + ks * 32 + lq * 8), a);
                    *(LAS f32x4*)(osm + (tt * 16 + lr) * 132 + w * 16 + 4 * lq) = a;
                }
            }
            {
                const f32x4 d4 = *(const LAS f32x4*)(dl + w * 16 + 4 * lq);
#pragma unroll
                for (int vt = 0; vt < 8; ++vt) st[vt] = st[vt] * d4;
#pragma unroll
                for (int ks = 0; ks < 2; ++ks) {
                    const bf16x8 A = *(const LAS bf16x8*)(keT + (w * 16 + lr) * 72 + ks * 32 + lq * 8);
#pragma unroll
                    for (int vt = 0; vt < 8; ++vt) st[vt] = mfma16(A, *(const LAS bf16x8*)(vT + (vt * 16 + lr) * 72 + ks * 32 + lq * 8), st[vt]);
                }
            }
            __syncthreads();
            {
                f32x4 x4[4];
#pragma unroll
                for (int i = 0; i < 4; ++i) x4[i] = *(const LAS f32x4*)(osm + vs * 132 + vv0 + i * 4);
                float ss = 0.f;
#pragma unroll
                for (int i = 0; i < 4; ++i) ss += x4[i][0] * x4[i][0] + x4[i][1] * x4[i][1] + x4[i][2] * x4[i][2] + x4[i][3] * x4[i][3];
                ss += __shfl_xor(ss, 1); ss += __shfl_xor(ss, 2); ss += __shfl_xor(ss, 4);
                const float rstd = 1.0f / sqrtf(ss * (1.0f / 128.0f) + 1e-6f);
                const unsigned gw_[8] = {gc0.x, gc0.y, gc0.z, gc0.w, gc1.x, gc1.y, gc1.z, gc1.w};
                unsigned ow[8];
#pragma unroll
                for (int i = 0; i < 4; ++i) {
                    const f32x4 y = x4[i] * rstd * ngv[i];
                    ow[2 * i] = pk(y[0] * blo(gw_[2 * i]), y[1] * bhi(gw_[2 * i]));
                    ow[2 * i + 1] = pk(y[2] * blo(gw_[2 * i + 1]), y[3] * bhi(gw_[2 * i + 1]));
                }
                *(u32x4*)(ab + vo) = (u32x4){ow[0], ow[1], ow[2], ow[3]};
                *(u32x4*)(ab + vo + 8) = (u32x4){ow[4], ow[5], ow[6], ow[7]};
            }
        }
#undef HG_LOAD
        __syncthreads();
    }
}

__device__ __forceinline__ void moba_block(const P& p, int b, int h, int n, LAS unsigned char* lds) {
    int tid = threadIdx.x; asm volatile("" : "+v"(tid));
    const int w = tid >> 6, lane = tid & 63, lr = lane & 15, lq = lane >> 4;
    LAS float* km = (LAS float*)lds;
    LAS bf16_t* ks_ = (LAS bf16_t*)(lds + 4096);
    LAS bf16_t* vT = (LAS bf16_t*)(lds + 4096 + 17408);
    const bf16_t* qg = p.s[0]; const bf16_t* kg = p.s[1]; const bf16_t* vg = p.s[2]; const bf16_t* sgg = p.s[3]; bf16_t* ab = p.ab;
    const size_t rowb = (size_t)b * SEQ;
    bf16x8 Qf[2][4];
#pragma unroll
    for (int qt = 0; qt < 2; ++qt)
#pragma unroll
        for (int kx = 0; kx < 4; ++kx) Qf[qt][kx] = *(const bf16x8*)(qg + (rowb + n * 256 + w * 32 + qt * 16 + lr) * DM + h * 128 + kx * 32 + lq * 8);
    const int ntiles = (n + 1) * 4;
    const bf16_t* vtg = vg + (size_t)((b * 8 + h) * 128) * SEQ;
    u32x4 pk_[2], pv_[2];
#define MB_LOAD(ti) do { const int _blk = (ti) >> 2; const int _j = _blk == 0 ? n : _blk - 1; const size_t _kb = (size_t)_j * 256 + ((ti) & 3) * 64; \
        _Pragma("unroll") for (int r = 0; r < 2; ++r) { const int ci = tid + 512 * r; \
            pk_[r] = *(const u32x4*)(kg + (rowb + _kb + (ci >> 4)) * DM + h * 128 + (ci & 15) * 8); \
            pv_[r] = *(const u32x4*)(vtg + (size_t)(ci >> 3) * SEQ + _kb + (ci & 7) * 8); } } while (0)
#define MB_STORE(bufi) do { LAS bf16_t* _ks = ks_ + (bufi) * 32768; LAS bf16_t* _vt = _ks + 64 * 136; \
        _Pragma("unroll") for (int r = 0; r < 2; ++r) { const int ci = tid + 512 * r; \
            *(LAS u32x4*)(_ks + (ci >> 4) * 136 + (ci & 15) * 8) = pk_[r]; *(LAS u32x4*)(_vt + (ci >> 3) * 72 + (ci & 7) * 8) = pv_[r]; } } while (0)
    u32x4 pk2[2], pv2[2];
    MB_LOAD(0);
    pk2[0] = pk_[0]; pk2[1] = pk_[1]; pv2[0] = pv_[0]; pv2[1] = pv_[1];
    MB_LOAD(1);
    float kmv[2];
#pragma unroll
    for (int r = 0; r < 2; ++r) kmv[r] = (tid + 512 * r < n * 128) ? p.kmean[(size_t)((b * 8 + h) * 8) * 128 + tid + 512 * r] : 0.f;
    __syncthreads();
    LAS bf16_t* km16 = (LAS bf16_t*)lds;
#pragma unroll
    for (int r = 0; r < 2; ++r) if (tid + 512 * r < n * 128) km16[tid + 512 * r] = f2bf(kmv[r]);
    __syncthreads();
    unsigned sel[2];
#pragma unroll
    for (int qt = 0; qt < 2; ++qt) {
        f32x4 gacc = (f32x4){0.f, 0.f, 0.f, 0.f};
#pragma unroll
        for (int kx = 0; kx < 4; ++kx) gacc = mfma16(*(const LAS bf16x8*)(km16 + lr * 128 + kx * 32 + lq * 8), Qf[qt][kx], gacc);
        float g[7];
        g[0] = gacc[0]; g[1] = gacc[1]; g[2] = gacc[2]; g[3] = gacc[3];
        g[4] = __shfl(gacc[0], lr + 16); g[5] = __shfl(gacc[1], lr + 16); g[6] = __shfl(gacc[2], lr + 16);
        unsigned s = 0;
        if (n <= 3) s = (1u << n) - 1u;
        else {
#pragma unroll
            for (int r = 0; r < 3; ++r) {
                float best = -3.0e38f; int bi = 0;
#pragma unroll
                for (int j = 0; j < 7; ++j) if (j < n && !((s >> j) & 1u) && g[j] > best) { best = g[j]; bi = j; }
                s |= 1u << bi;
            }
        }
        sel[qt] = __shfl(s, lr);
    }
    float mrow[2] = {-1e30f, -1e30f}, lrow[2] = {0.f, 0.f};
    f32x4 O[8][2];
#pragma unroll
    for (int dt = 0; dt < 8; ++dt) { O[dt][0] = (f32x4){0.f, 0.f, 0.f, 0.f}; O[dt][1] = (f32x4){0.f, 0.f, 0.f, 0.f}; }
    for (int ti = 0; ti < ntiles; ++ti) {
        const int blk = ti >> 2, tile = ti & 3;
        const int j = blk == 0 ? n : blk - 1; const bool own = blk == 0;
        if ((ti & 1) == 0) {
            __syncthreads();
            { LAS bf16_t* _ks = ks_; LAS bf16_t* _vt = _ks + 64 * 136;
#pragma unroll
              for (int r = 0; r < 2; ++r) { const int ci = tid + 512 * r;
                *(LAS u32x4*)(_ks + (ci >> 4) * 136 + (ci & 15) * 8) = pk2[r]; *(LAS u32x4*)(_vt + (ci >> 3) * 72 + (ci & 7) * 8) = pv2[r]; } }
            MB_STORE(1);
            __syncthreads();
            if (ti + 2 < ntiles) {
                MB_LOAD(ti + 2);
                pk2[0] = pk_[0]; pk2[1] = pk_[1]; pv2[0] = pv_[0]; pv2[1] = pv_[1];
                MB_LOAD(ti + 3);
            }
        }
        const LAS bf16_t* kbuf = ks_ + (ti & 1) * 32768; const LAS bf16_t* vbuf = kbuf + 64 * 136;
        const bool lane_need = (((sel[0] | sel[1]) >> j) & 1u) != 0;
        const bool need = own ? (tile * 64 <= w * 32 + 31) : (__ballot(lane_need) != 0ull);
        if (need) {
            f32x4 sT[4][2];
#pragma unroll
            for (int kt = 0; kt < 4; ++kt) { sT[kt][0] = (f32x4){0.f, 0.f, 0.f, 0.f}; sT[kt][1] = (f32x4){0.f, 0.f, 0.f, 0.f}; }
#pragma unroll
            for (int kt = 0; kt < 4; ++kt)
#pragma unroll
                for (int kx = 0; kx < 4; ++kx) {
                    const bf16x8 A = *(const LAS bf16x8*)(kbuf + (kt * 16 + lr) * 136 + kx * 32 + lq * 8);
                    sT[kt][0] = mfma16(A, Qf[0][kx], sT[kt][0]); sT[kt][1] = mfma16(A, Qf[1][kx], sT[kt][1]);
                    if (kx == 3) __builtin_amdgcn_sched_barrier(0);
                }
            const bool diag = own && (tile * 64 + 63 > w * 32);
#pragma unroll
            for (int qt = 0; qt < 2; ++qt) {
                const int qq = w * 32 + qt * 16 + lr;
                const bool selj = own || (((sel[qt] >> j) & 1u) != 0);
                if (diag) {
#pragma unroll
                    for (int kt = 0; kt < 4; ++kt)
#pragma unroll
                        for (int i = 0; i < 4; ++i) { const int key = tile * 64 + kt * 16 + 4 * lq + i; sT[kt][qt][i] = key <= qq ? sT[kt][qt][i] : -1e30f; }
                }
                float mx = fmaxf(fmaxf(fmaxf(sT[0][qt][0], sT[0][qt][1]), fmaxf(sT[0][qt][2], sT[0][qt][3])), fmaxf(fmaxf(sT[1][qt][0], sT[1][qt][1]), fmaxf(sT[1][qt][2], sT[1][qt][3])));
                mx = fmaxf(mx, fmaxf(fmaxf(fmaxf(sT[2][qt][0], sT[2][qt][1]), fmaxf(sT[2][qt][2], sT[2][qt][3])), fmaxf(fmaxf(sT[3][qt][0], sT[3][qt][1]), fmaxf(sT[3][qt][2], sT[3][qt][3]))));
                mx = xmax_16_32(mx);
                const float cand = selj ? mx : -3.0e38f;
                float alpha = 1.0f;
                if (!__all(cand - mrow[qt] <= 8.0f)) {
                    const float mnew = fmaxf(mrow[qt], cand);
                    alpha = __builtin_amdgcn_exp2f(mrow[qt] - mnew);
                    mrow[qt] = mnew;
#pragma unroll
                    for (int dt = 0; dt < 8; ++dt) O[dt][qt] = O[dt][qt] * alpha;
                }
                const float msub = selj ? mrow[qt] : 1e30f;
                float ps = 0.f;
#pragma unroll
                for (int kt = 0; kt < 4; ++kt)
#pragma unroll
                    for (int i = 0; i < 4; ++i) { const float pv = __builtin_amdgcn_exp2f(sT[kt][qt][i] - msub); ps += pv; sT[kt][qt][i] = pv; }
                lrow[qt] = lrow[qt] * alpha + ps;
            }
#pragma unroll
            for (int kg2 = 0; kg2 < 2; ++kg2) {
                bf16x8 pf[2];
#pragma unroll
                for (int qt = 0; qt < 2; ++qt) {
                    const u32x4 pw = pack8(sT[2 * kg2][qt], sT[2 * kg2 + 1][qt]);
                    pf[qt] = __builtin_bit_cast(bf16x8, pw);
                }
#pragma unroll
                for (int dt = 0; dt < 8; ++dt) {
                    const u32x2 lo = *(const LAS u32x2*)(vbuf + (dt * 16 + lr) * 72 + kg2 * 32 + 4 * lq);
                    const u32x2 hi = *(const LAS u32x2*)(vbuf + (dt * 16 + lr) * 72 + kg2 * 32 + 16 + 4 * lq);
                    const u32x4 vw = (u32x4){lo.x, lo.y, hi.x, hi.y};
                    const bf16x8 vf = __builtin_bit_cast(bf16x8, vw);
                    O[dt][0] = mfma16(vf, pf[0], O[dt][0]); O[dt][1] = mfma16(vf, pf[1], O[dt][1]);
                    if (dt & 1) __builtin_amdgcn_sched_barrier(0);
                }
            }
        }
    }
#undef MB_LOAD
#undef MB_STORE
#pragma unroll
    for (int qt = 0; qt < 2; ++qt) {
        const float l = xsum_16_32(lrow[qt]);
        const float inv = 1.0f / l;
        const int odd = lq & 1;
        const size_t ro = (rowb + n * 256 + w * 32 + qt * 16 + lr) * DM + h * 128 + 4 * (lq & 2);
        u32x4 gg[4];
#pragma unroll
        for (int dp = 0; dp < 4; ++dp) gg[dp] = *(const u32x4*)(sgg + ro + (2 * dp + odd) * 16);
#pragma unroll
        for (int dp = 0; dp < 4; ++dp) {
            const f32x4 ya = O[2 * dp][qt] * inv, yb = O[2 * dp + 1][qt] * inv;
            f32x4 lo4, hi4;
#pragma unroll
            for (int i = 0; i < 4; ++i) {
                const auto sw = __builtin_amdgcn_permlane16_swap(__float_as_uint(ya[i]), __float_as_uint(yb[i]), false, false);
                lo4[i] = __uint_as_float(sw[0]); hi4[i] = __uint_as_float(sw[1]);
            }
            const u32x4 g = gg[dp];
            lo4[0] *= blo(g.x); lo4[1] *= bhi(g.x); lo4[2] *= blo(g.y); lo4[3] *= bhi(g.y);
            hi4[0] *= blo(g.z); hi4[1] *= bhi(g.z); hi4[2] *= blo(g.w); hi4[3] *= bhi(g.w);
            *(u32x4*)(ab + ro + (2 * dp + odd) * 16) = pack8(lo4, hi4);
        }
    }
}

__device__ __forceinline__ void moba_phase(const P& p, LAS unsigned char* lds) {
    for (int it = blockIdx.x; it < 512; it += gridDim.x) {
        const int pi = it & 3, bh = it >> 2, b = bh >> 3, h = bh & 7;
        for (int half = 0; half < 2; ++half) moba_block(p, b, h, half ? pi : 7 - pi, lds);
    }
}

__device__ __forceinline__ void s5_scan(const P& p, LAS unsigned char* lds) {
    LAS float* Es = (LAS float*)lds;
    LAS bf16_t* Tl = (LAS bf16_t*)lds;
    LAS bf16_t* Hp = (LAS bf16_t*)(lds + 67584);
    LAS float* wsum = (LAS float*)(lds + 102400);
    LAS bf16_t* SA = (LAS bf16_t*)(lds + 106496);
    for (int q = blockIdx.x; q < 256; q += gridDim.x)
    for (int bi = 0; bi < 4; ++bi) {
        int tid = threadIdx.x; asm volatile("" : "+v"(tid));
        const int w = tid >> 6, lane = tid & 63, lr = lane & 15, lq = lane >> 4;
        const int g = q >> 2, b = (q & 3) * 4 + bi;
        const bf16_t* u = p.s[0] + (size_t)(g * 16 + b) * SEQ * 16;
        bf16_t* yo = p.s[1] + (size_t)b * SEQ * DM + g * 16;
        const bf16_t* W1 = p.s5w1 + (size_t)g * 32768; const bf16_t* T = p.s5t + (size_t)g * 65536; const bf16_t* W2 = p.s5w2 + (size_t)g * 32768;
        bf16x8 Uf[8];
#pragma unroll
        for (int ks = 0; ks < 8; ++ks) Uf[ks] = *(const bf16x8*)(u + (unsigned)(((16 * w + lr) * 16 + 2 * ks + (lq >> 1)) * 16 + 8 * (lq & 1)));
        const f32x4 d4 = *(const f32x4*)(p.dskip + g * 16 + 4 * lq);
        const float ar = p.a16[(g * 64 + lane) * 2], ai = p.a16[(g * 64 + lane) * 2 + 1];
#pragma unroll 1
        for (int hh = 0; hh < 2; ++hh) {
            u32x4 r4[4];
#pragma unroll
            for (int r = 0; r < 4; ++r) { const int ci = tid + 512 * r; r4[r] = *(const u32x4*)(W1 + (unsigned)((hh * 64 + (ci >> 5)) * 256 + (ci & 31) * 8)); }
            __syncthreads();
#pragma unroll
            for (int r = 0; r < 4; ++r) { const int ci = tid + 512 * r; *(LAS u32x4*)(SA + (ci >> 5) * 264 + (ci & 31) * 8) = r4[r]; }
            __syncthreads();
#pragma unroll
            for (int n4 = 0; n4 < 4; ++n4) {
                f32x4 e = (f32x4){0.f, 0.f, 0.f, 0.f};
#pragma unroll
                for (int ks = 0; ks < 8; ++ks) e = mfma16(Uf[ks], *(const LAS bf16x8*)(SA + (n4 * 16 + lr) * 264 + ks * 32 + lq * 8), e);
                const int nt = hh * 4 + n4;
#pragma unroll
                for (int i = 0; i < 4; ++i) Es[(16 * w + 4 * lq + i) * 132 + nt * 16 + lr] = e[i];
                __builtin_amdgcn_sched_barrier(0);
            }
        }
        __syncthreads();
        {
            float hr = 0.f, hi = 0.f;
#pragma unroll
            for (int c = 0; c < 16; ++c) {
                const float er = Es[(16 * w + c) * 132 + lane], ei = Es[(16 * w + c) * 132 + 64 + lane];
                const float nr = ar * hr - ai * hi + er, ni = ar * hi + ai * hr + ei; hr = nr; hi = ni;
            }
            wsum[w * 128 + lane] = hr; wsum[w * 128 + 64 + lane] = hi;
        }
        __syncthreads();
        {
            float pr = ar, pi = ai;
#pragma unroll
            for (int i = 0; i < 4; ++i) { const float nr = pr * pr - pi * pi, ni = 2.0f * pr * pi; pr = nr; pi = ni; }
            float hr = 0.f, hi = 0.f;
            for (int w2 = 0; w2 < w; ++w2) {
                const float lr_ = wsum[w2 * 128 + lane], li_ = wsum[w2 * 128 + 64 + lane];
                const float nr = pr * hr - pi * hi + lr_, ni = pr * hi + pi * hr + li_; hr = nr; hi = ni;
            }
#pragma unroll
            for (int c = 0; c < 16; ++c) {
                Hp[(16 * w + c) * 136 + lane] = f2bf(hr); Hp[(16 * w + c) * 136 + 64 + lane] = f2bf(hi);
                const float er = Es[(16 * w + c) * 132 + lane], ei = Es[(16 * w + c) * 132 + 64 + lane];
                const float nr = ar * hr - ai * hi + er, ni = ar * hi + ai * hr + ei; hr = nr; hi = ni;
            }
        }
        u32x4 t4[8], w4[4]; u32x2 uu[8];
        const bf16_t* up = u + (size_t)((16 * w + lr) * 16) * 16 + 4 * lq;
#pragma unroll
        for (int r = 0; r < 8; ++r) { const int ci = tid + 512 * r; t4[r] = *(const u32x4*)(T + (unsigned)((ci >> 5) * 256 + (ci & 31) * 8)); }
#pragma unroll
        for (int r = 0; r < 4; ++r) { const int ci = tid + 512 * r; w4[r] = *(const u32x4*)(W2 + (unsigned)((ci >> 4) * 128 + (ci & 15) * 8)); }
#pragma unroll
        for (int nt = 0; nt < 8; ++nt) { uu[nt] = *(const u32x2*)(up); up += 16; asm volatile("" : "+v"(up)); }
        __syncthreads();
        bf16x8 Hf[4];
#pragma unroll
        for (int ks = 0; ks < 4; ++ks) Hf[ks] = *(const LAS bf16x8*)(Hp + (16 * w + lr) * 136 + ks * 32 + lq * 8);
        bf16_t* yp = yo + (size_t)((16 * w + lr) * 16) * DM + 4 * lq;
#pragma unroll
        for (int hh = 0; hh < 2; ++hh) {
            if (hh == 1) {
                __syncthreads();
#pragma unroll
                for (int r = 0; r < 8; ++r) { const int ci = tid + 512 * r; t4[r] = *(const u32x4*)(T + (unsigned)((128 + (ci >> 5)) * 256 + (ci & 31) * 8)); }
#pragma unroll
                for (int r = 0; r < 4; ++r) { const int ci = tid + 512 * r; w4[r] = *(const u32x4*)(W2 + (unsigned)((128 + (ci >> 4)) * 128 + (ci & 15) * 8)); }
#pragma unroll
                for (int nt = 0; nt < 8; ++nt) { uu[nt] = *(const u32x2*)(up); up += 16; asm volatile("" : "+v"(up)); }
            }
#pragma unroll
            for (int r = 0; r < 8; ++r) { const int ci = tid + 512 * r; *(LAS u32x4*)(Tl + (ci >> 5) * 264 + (ci & 31) * 8) = t4[r]; }
#pragma unroll
            for (int r = 0; r < 4; ++r) { const int ci = tid + 512 * r; *(LAS u32x4*)(SA + (ci >> 4) * 136 + (ci & 15) * 8) = w4[r]; }
            __syncthreads();
#pragma unroll
            for (int n8 = 0; n8 < 8; ++n8) {
                f32x4 y = (f32x4){0.f, 0.f, 0.f, 0.f};
#pragma unroll
                for (int ks = 0; ks < 8; ++ks) if (ks <= ((hh * 8 + n8) >> 1)) y = mfma16(*(const LAS bf16x8*)(Tl + (n8 * 16 + lr) * 264 + ks * 32 + lq * 8), Uf[ks], y);
#pragma unroll
                for (int ks = 0; ks < 4; ++ks) y = mfma16(*(const LAS bf16x8*)(SA + (n8 * 16 + lr) * 136 + ks * 32 + lq * 8), Hf[ks], y);
                const u32x2 u2 = uu[n8];
                f32x4 r;
                r[0] = geluf_(y[0] + d4[0] * blo(u2.x)); r[1] = geluf_(y[1] + d4[1] * bhi(u2.x));
                r[2] = geluf_(y[2] + d4[2] * blo(u2.y)); r[3] = geluf_(y[3] + d4[3] * bhi(u2.y));
                *(u32x2*)(yp) = pack4(r); yp += DM; asm volatile("" : "+v"(yp));
                __builtin_amdgcn_sched_barrier(0);
            }
        }
        __syncthreads();
    }
}

__device__ __forceinline__ void g2_phase(const P& p, int layer, int en, LAS unsigned char* lds) {
    for (int half = 0; half < 2; ++half) {
        EpiOutLn E; E.res = p.x; E.dst = p.out; E.xb = p.xb; E.xlo = p.xlo; E.g = p.ln_g[layer]; E.bb = p.ln_b[layer];
        E.X = p.lnx + (size_t)layer * 128 * 4 * 256 * 2; E.cnt = p.lncnt + layer * 128; E.pm_off = half * 64; E.use_acc = en; E.last = layer == 3; E.split_in = layer != 0;
        gemm_phase(lds, p.ab + (size_t)half * 16384 * DM, p.wt_out[layer], 16384, 1024, 1024, E);
    }
}

__global__ void __launch_bounds__(512, 2) fwd(P p) {
    extern __shared__ __attribute__((aligned(16))) unsigned char shm[];
    LAS unsigned char* lds = (LAS unsigned char*)shm;
    cg::grid_group grid = cg::this_grid();
    volatile LAS unsigned* xst = (volatile LAS unsigned*)(lds + 152576);
    if (threadIdx.x == 0) { xst[0] = 0u; xst[1] = 0u; }
    __syncthreads();
    const XcdBarrier xb = xcd_barrier_post(p.bar, xst);
    if (p.ph_hi < 0) grid.sync();
#ifndef DUP
#define DUP -1
#endif
#define PHASE(k, body) if (p.ph_lo <= (k) && (k) < p.ph_hi) { if ((k) > p.ph_lo) { xcd_barrier(xb); } if (PH_ON(k)) { body } if ((k) == DUP) { grid.sync(); body } }
#define HG1(L) { EpiHgrn E; E.q = p.s[0]; E.lf = p.out; E.v = p.s[2]; E.sg = p.s[3]; E.lb = p.lb + (L) * 1024; gemm_phase(lds, p.xb, p.wt_in[L], NTOK, 4096, 1024, E); }
    PHASE(0, prologue(p, lds);)
    PHASE(1, if (EN_L0) HG1(0))
    PHASE(2, if (EN_L0) hgrn_scan(p, 0, lds); if (gridDim.x >= 256) { if (blockIdx.x >= 128) prologue_b(p, (int)blockIdx.x - 128, (int)gridDim.x - 128, lds); } else prologue_b(p, (int)blockIdx.x, (int)gridDim.x, lds);)
    PHASE(3, g2_phase(p, 0, EN_L0, lds);)
    PHASE(5, if (EN_L1) { EpiMoba E; E.q = p.s[0]; E.k = p.s[1]; E.v = p.s[2]; E.sg = p.s[3]; E.rope = p.rope; E.kmean = p.kmean; gemm_phase(lds, p.xb, p.wt_in[1], NTOK, 4096, 1024, E); })
    PHASE(6, if (EN_L1) moba_phase(p, lds);)
    PHASE(7, g2_phase(p, 1, EN_L1, lds);)
    PHASE(9, if (EN_L2) { EpiS5 E; E.u = p.s[0]; E.sg = p.s[3]; gemm_phase(lds, p.xb, p.wt_in[2], NTOK, 2048, 1024, E); })
    PHASE(10, if (EN_L2) s5_scan(p, lds);)
    PHASE(11, if (EN_L2) { EpiGlu E; E.y = p.s[1]; E.sg = p.s[3]; E.bias = p.b_glu; E.o = p.ab; gemm_phase(lds, p.s[1], p.wt_glu, NTOK, 1024, 1024, E); })
    PHASE(12, g2_phase(p, 2, EN_L2, lds);)
    PHASE(14, if (EN_L3) HG1(3))
    PHASE(15, if (EN_L3) hgrn_scan(p, 3, lds);)
    PHASE(16, g2_phase(p, 3, EN_L3, lds);)
#ifdef SYNC_PROBE
    for (int i = 0; i < 8; ++i) grid.sync();
#endif
}

extern "C" void kernel_launch(void* const* d_in, const int* in_sizes, int n_in, void* d_out, int out_size, void* d_ws, size_t ws_size, hipStream_t stream) {
    static int grid_blocks = 0;
    if (!grid_blocks) {
        int dev = 0, cus = 0, per_cu = 0;
        hipGetDevice(&dev);
        hipDeviceGetAttribute(&cus, hipDeviceAttributeMultiprocessorCount, dev);
        hipFuncSetAttribute((const void*)fwd, hipFuncAttributeMaxDynamicSharedMemorySize, LDS_BYTES);
        hipOccupancyMaxActiveBlocksPerMultiprocessor(&per_cu, (const void*)fwd, 512, LDS_BYTES);
        if (per_cu < 1) { fprintf(stderr, "kernel_launch: occupancy query says %d blocks/CU\n", per_cu); per_cu = 1; }
        grid_blocks = cus * 1;
        (void)hipGetLastError();
    }
    P p{};
    const float* const* in = (const float* const*)d_in;
    p.x = in[0]; p.lbl = in[1];
    p.w_in[0] = in[2]; p.norm_g[0] = in[3]; p.w_out[0] = in[4]; p.ln_g[0] = in[5]; p.ln_b[0] = in[6];
    p.w_in[1] = in[7]; p.w_out[1] = in[8]; p.ln_g[1] = in[9]; p.ln_b[1] = in[10]; p.norm_g[1] = in[3];
    p.w_in[2] = in[11]; p.a_re = in[12]; p.a_im = in[13]; p.log_dt = in[14]; p.b_re = in[15]; p.b_im = in[16]; p.c_re = in[17]; p.c_im = in[18];
    p.dskip = in[19]; p.w_glu = in[20]; p.b_glu = in[21]; p.w_out[2] = in[22]; p.ln_g[2] = in[23]; p.ln_b[2] = in[24]; p.norm_g[2] = in[3];
    p.w_in[3] = in[25]; p.norm_g[3] = in[26]; p.w_out[3] = in[27]; p.ln_g[3] = in[28]; p.ln_b[3] = in[29];
    p.out = (float*)d_out;
    unsigned char* ws = (unsigned char*)d_ws; size_t off = 0;
    auto take = [&](size_t bytes) { unsigned char* r = ws + off; off += (bytes + 255) & ~(size_t)255; return r; };
    const size_t MD2 = (size_t)NTOK * DM * 2;
    p.xb = (bf16_t*)take(MD2); p.xf = (float*)take(MD2 * 2);
    p.xlo = (bf16_t*)p.xf; p.ab = (bf16_t*)p.xf + (size_t)NTOK * DM;
    for (int i = 0; i < 4; ++i) p.s[i] = (bf16_t*)take(MD2);
    p.wt_in[0] = (bf16_t*)take(4096 * 1024 * 2); p.wt_in[1] = (bf16_t*)take(4096 * 1024 * 2); p.wt_in[2] = (bf16_t*)take(2048 * 1024 * 2); p.wt_in[3] = (bf16_t*)take(4096 * 1024 * 2);
    for (int i = 0; i < 4; ++i) p.wt_out[i] = (bf16_t*)take(1024 * 1024 * 2);
    p.wt_glu = (bf16_t*)take(1024 * 1024 * 2);
    p.s5w1 = (bf16_t*)take(64 * 32768 * 2); p.s5t = (bf16_t*)take(64 * 65536 * 2); p.s5w2 = (bf16_t*)take(64 * 32768 * 2);
    p.lb = (float*)take(4096 * 4); p.rope = (float*)take(SEQ * 64 * 2 * 4); p.kmean = (float*)take(16 * 8 * 8 * 128 * 4); p.a16 = (float*)take(64 * 64 * 2 * 4); p.lnx = (float*)take(4 * 128 * 4 * 256 * 2 * 4); p.lncnt = (unsigned*)take(512 * 4); p.bar = (unsigned*)take(XCD_BAR_WORDS * 4);
    if (off > ws_size) { fprintf(stderr, "kernel_launch: workspace too small: need %zu have %zu\n", off, ws_size); return; }
    (void)hipMemsetAsync(p.bar, 0, XCD_BAR_WORDS * 4, stream);
#if MODE_SINGLE
    p.ph_lo = 0; p.ph_hi = NPHASE;
    void* args[] = {&p};
    hipError_t e = hipLaunchCooperativeKernel((const void*)fwd, dim3(grid_blocks), dim3(512), args, LDS_BYTES, stream);
    if (e != hipSuccess) fprintf(stderr, "cooperative launch failed: %s (grid %d)\n", hipGetErrorString(e), grid_blocks);
#else
    for (int ph = 0; ph < NPHASE; ++ph) {
        p.ph_lo = ph; p.ph_hi = ph + 1;
        hipLaunchKernelGGL(fwd, dim3(grid_blocks), dim3(512), LDS_BYTES, stream, p);
    }
#endif
}
```

```cpp
#include <hip/hip_runtime.h>
#include <hip/hip_cooperative_groups.h>
#include <cstdio>
namespace cg = cooperative_groups;

#ifndef MODE_SINGLE
#define MODE_SINGLE 1
#endif
#ifndef EN_L0
#define EN_L0 1
#endif
#ifndef EN_L1
#define EN_L1 1
#endif
#ifndef EN_L2
#define EN_L2 1
#endif
#ifndef EN_L3
#define EN_L3 1
#endif

#ifndef PHMASK
#define PHMASK 0x3ffff
#endif
#define PH_ON(k) (((PHMASK) >> (k)) & 1)
#define LAS __attribute__((address_space(3)))
typedef unsigned short bf16_t;
typedef short bf16x8 __attribute__((ext_vector_type(8)));
typedef float f32x4 __attribute__((ext_vector_type(4)));
typedef unsigned u32x4 __attribute__((ext_vector_type(4)));
typedef unsigned u32x2 __attribute__((ext_vector_type(2)));

constexpr int SEQ = 2048, DM = 1024, NTOK = 32768;
constexpr int LDS_BYTES = 152576 + 16;
constexpr float ALPHA = 1.681792830507429f;
constexpr int NPHASE = 18;

struct P {
    const float* x; const float* lbl;
    const float* w_in[4]; const float* w_out[4]; const float* ln_g[4]; const float* ln_b[4]; const float* norm_g[4];
    const float *a_re, *a_im, *log_dt, *b_re, *b_im, *c_re, *c_im, *dskip, *w_glu, *b_glu;
    float* out;
    bf16_t* wt_in[4]; bf16_t* wt_out[4]; bf16_t* wt_glu;
    bf16_t* xb; float* xf; bf16_t* s[4];
    float* lb; float* rope; float* kmean; float* a16; float* lnx; unsigned* lncnt; unsigned* bar;
    bf16_t* s5w1; bf16_t* s5t; bf16_t* s5w2;
    int ph_lo, ph_hi;
};

__device__ __forceinline__ unsigned pk(float lo, float hi) { unsigned r; asm("v_cvt_pk_bf16_f32 %0, %1, %2" : "=v"(r) : "v"(lo), "v"(hi)); return r; }
__device__ __forceinline__ bf16_t f2bf(float v) { return (bf16_t)(pk(v, 0.f) & 0xffffu); }
__device__ __forceinline__ float bf2f(bf16_t u) { return __uint_as_float(((unsigned)u) << 16); }
__device__ __forceinline__ float blo(unsigned w) { return __uint_as_float(w << 16); }
__device__ __forceinline__ float bhi(unsigned w) { return __uint_as_float(w & 0xffff0000u); }
__device__ __forceinline__ u32x4 pack8(f32x4 a, f32x4 b) { u32x4 w; w.x = pk(a[0], a[1]); w.y = pk(a[2], a[3]); w.z = pk(b[0], b[1]); w.w = pk(b[2], b[3]); return w; }
__device__ __forceinline__ u32x2 pack4(f32x4 a) { u32x2 w; w.x = pk(a[0], a[1]); w.y = pk(a[2], a[3]); return w; }
__device__ __forceinline__ float sigmoidf_(float v) { return __builtin_amdgcn_rcpf(1.0f + __builtin_amdgcn_exp2f(-1.4426950408889634f * v)); }
__device__ __forceinline__ float siluf_(float v) { return v * __builtin_amdgcn_rcpf(1.0f + __builtin_amdgcn_exp2f(-1.4426950408889634f * v)); }
__device__ __forceinline__ float geluf_(float v) { const float u = -2.3022081943418046f * (v + 0.044715f * v * v * v); return v * __builtin_amdgcn_rcpf(1.0f + __builtin_amdgcn_exp2f(u)); }
__device__ __forceinline__ float xmax_16_32(float x) {
    auto a = __builtin_amdgcn_permlane16_swap(__float_as_uint(x), __float_as_uint(x), false, false);
    const float y = fmaxf(__uint_as_float(a[0]), __uint_as_float(a[1]));
    auto b = __builtin_amdgcn_permlane32_swap(__float_as_uint(y), __float_as_uint(y), false, false);
    return fmaxf(__uint_as_float(b[0]), __uint_as_float(b[1]));
}
__device__ __forceinline__ float xsum_16_32(float x) {
    auto a = __builtin_amdgcn_permlane16_swap(__float_as_uint(x), __float_as_uint(x), false, false);
    const float y = __uint_as_float(a[0]) + __uint_as_float(a[1]);
    auto b = __builtin_amdgcn_permlane32_swap(__float_as_uint(y), __float_as_uint(y), false, false);
    return __uint_as_float(b[0]) + __uint_as_float(b[1]);
}
__device__ __forceinline__ f32x4 mfma16(bf16x8 a, bf16x8 b, f32x4 c) { return __builtin_amdgcn_mfma_f32_16x16x32_bf16(a, b, c, 0, 0, 0); }


#define XB_TMO      128
#define XB_XCNT(j)  (256  + 64 * (j))
#define XB_XSUB(j)  (1280 + 64 * (j))
#define XB_XGEN(j)  (2304 + 64 * (j))
#define XB_TOP      3328
#define XB_TOPGEN   3392
#define XCD_BAR_WORDS 3456
#define XB_SPIN_CAP (1u << 18)
__device__ __forceinline__ unsigned xb_ld(unsigned* p)              { return __hip_atomic_load(p, __ATOMIC_RELAXED, __HIP_MEMORY_SCOPE_AGENT); }
__device__ __forceinline__ unsigned xb_add(unsigned* p, unsigned v) { return __hip_atomic_fetch_add(p, v, __ATOMIC_RELAXED, __HIP_MEMORY_SCOPE_AGENT); }
__device__ __forceinline__ unsigned xb_xcc_id() { return (unsigned)__builtin_amdgcn_s_getreg((3 << 11) | 20) & 0xFu; }
#define XB_SPIN(cond, bar) do { unsigned _sp = 0; while (cond) { __builtin_amdgcn_s_sleep(1); \
    if ((++_sp & 255u) == 0u) { if (xb_ld(&(bar)[XB_TMO])) break; if (_sp > XB_SPIN_CAP) { atomicAdd(&(bar)[XB_TMO], 1u); break; } } } } while (0)
struct XcdBarrier { unsigned* bar; unsigned x; volatile LAS unsigned* st; };
__device__ __forceinline__ XcdBarrier xcd_barrier_post(unsigned* bar, volatile LAS unsigned* st) {
    XcdBarrier b; b.bar = bar; b.x = xb_xcc_id(); b.st = st;
    if (threadIdx.x == 0) (void)xb_add(&bar[XB_XCNT(b.x)], 1u);
    return b;
}
__device__ __forceinline__ void xcd_barrier_complete(unsigned* bar, unsigned x, unsigned& nloc, unsigned& nx) {
    const unsigned G = gridDim.x * gridDim.y * gridDim.z;
    unsigned sum, cnt, mine, sp = 0u;
    for (;;) {
        sum = 0u; cnt = 0u; mine = 0u;
#pragma unroll
        for (unsigned j = 0; j < 16; ++j) { const unsigned c = xb_ld(&bar[XB_XCNT(j)]); sum += c; cnt += (c > 0u) ? 1u : 0u; mine = (j == x) ? c : mine; }
        if (sum == G) break;
        __builtin_amdgcn_s_sleep(1);
        if ((++sp & 255u) == 0u) { if (xb_ld(&bar[XB_TMO])) break; if (sp > XB_SPIN_CAP) { atomicAdd(&bar[XB_TMO], 1u); break; } }
    }
    nloc = mine > 0u ? mine : 1u; nx = cnt > 0u ? cnt : 1u;
}
__device__ __forceinline__ void xcd_barrier(const XcdBarrier& b) {
    asm volatile("s_waitcnt vmcnt(0)" ::: "memory");
    __syncthreads();
    if (threadIdx.x == 0) {
        unsigned* bar = b.bar;
        __builtin_amdgcn_s_waitcnt(0);
        unsigned nloc = b.st[0], nx = b.st[1];
        if (nloc == 0u) { xcd_barrier_complete(bar, b.x, nloc, nx); b.st[0] = nloc; b.st[1] = nx; }
        const unsigned old = xb_add(&bar[XB_XSUB(b.x)], 1u);
        const unsigned gen = old / nloc;
        if (old + 1u == (gen + 1u) * nloc) {
            __builtin_amdgcn_fence(__ATOMIC_RELEASE, "agent");
            asm volatile("s_waitcnt vmcnt(0)" ::: "memory");
            const unsigned og = xb_add(&bar[XB_TOP], 1u);
            const unsigned tg = og / nx;
            if (og + 1u == (tg + 1u) * nx) xb_add(&bar[XB_TOPGEN], 1u);
            else XB_SPIN(xb_ld(&bar[XB_TOPGEN]) == tg, bar);
            __builtin_amdgcn_fence(__ATOMIC_ACQUIRE, "agent");
            xb_add(&bar[XB_XGEN(b.x)], 1u);
            asm volatile("s_waitcnt vmcnt(0)" ::: "memory");
        } else {
            XB_SPIN(xb_ld(&bar[XB_XGEN(b.x)]) == gen, bar);
            __builtin_amdgcn_fence(__ATOMIC_ACQUIRE, "agent");
            asm volatile("s_waitcnt vmcnt(0)" ::: "memory");
        }
    }
    __syncthreads();
}

constexpr int BM = 256, BK = 64, HALF = 128, HTB = HALF * BK * 2, NXCD = 8, WGM = 8;
__device__ __forceinline__ int lds_byte(int r, int c) { const int st = (r >> 4) * 2 + (c >> 5), rr = r & 15, cc = c & 31, ob = rr * 64 + cc * 2; return st * 1024 + (ob ^ (((ob >> 9) & 1) << 5)); }
__device__ __forceinline__ void stage_rc(int b, int& R, int& C) { const int st = b / 1024, sb = b % 1024, swz = sb ^ (((sb >> 9) & 1) << 5); R = (st >> 1) * 16 + swz / 64; C = (st & 1) * 32 + (swz % 64) / 2; }
__device__ __forceinline__ int perm32(int rho) { const int n = rho >> 4, i = rho & 15; return 8 * (i >> 2) + 4 * n + (i & 3); }
struct Unit { int pm, pn; };
struct StaticOrder {
    int nM, nN, nwg, G, c;
    __device__ void init(int M, int N, int G_, int c_) { nM = M / BM; nN = N / BM; nwg = nM * nN; G = G_; c = c_; }
    __device__ bool next(int i, Unit& u) const {
        const long L = (long)i * G + c; if (L >= nwg) return false;
        int wgid = (int)L; { const int q = nwg / NXCD, r = nwg % NXCD, xcd = wgid % NXCD, off = wgid / NXCD; wgid = (xcd < r ? xcd * (q + 1) : r * (q + 1) + (xcd - r) * q) + off; }
        const int nig = WGM * nN, gid = wgid / nig, fm = gid * WGM, gsz = (nM - fm) < WGM ? (nM - fm) : WGM;
        u.pm = fm + ((wgid % nig) % gsz); u.pn = (wgid % nig) / gsz; return true;
    }
};

template <class Epi>
__device__ __forceinline__ void gemm_phase(LAS unsigned char* lds, const bf16_t* A, const bf16_t* Bt, int M, int N, int K, const Epi& E) {
    const int tid = threadIdx.x, wid = __builtin_amdgcn_readfirstlane(tid >> 6), lane = tid & 63, wr = wid >> 2, wc = wid & 3, fr = lane & 15, fq = lane >> 4;
    const int nt = K / BK;
    StaticOrder S; S.init(M, N, (int)gridDim.x, (int)blockIdx.x);
    unsigned voffA[2], voffB[2];
#pragma unroll
    for (int i = 0; i < 2; ++i) { int R, C; stage_rc(tid * 16 + i * 8192, R, C); const int Rb = Epi::PERM ? ((R & ~31) + perm32(R & 31)) : R;
        voffA[i] = (unsigned)(R * K + C) * 2u; voffB[i] = (unsigned)(Rb * K + C) * 2u; }
    const size_t kstep = (size_t)(BK * 2);
    const size_t hstep = (size_t)HALF * K * 2;
    const size_t tstep = 2 * hstep;
    const unsigned ldsw = (unsigned)wid * 1024u;
    const int aoff = lds_byte(wr * 64 + fr, fq * 8), boff = lds_byte(wc * 32 + fr, fq * 8);
#define G_SA(b, h) (((b) * 2 + (h)) * HTB)
#define G_SB(b, h) ((4 + (b) * 2 + (h)) * HTB)
#define G_STAGE(bufoff, gbase, voff) do { _Pragma("unroll") for (int _i = 0; _i < 2; ++_i) \
        __builtin_amdgcn_global_load_lds((const unsigned*)((const char*)(gbase) + (voff)[_i]), (LAS unsigned*)(lds + (bufoff) + ldsw + _i * 8192), 16, 0, 0); } while (0)
#define G_LDA(dst, b, h) do { _Pragma("unroll") for (int m = 0; m < 4; ++m) _Pragma("unroll") for (int k = 0; k < 2; ++k) dst[m][k] = *(const LAS bf16x8*)(lds + G_SA(b, h) + aoff + m * 2048 + k * 1024); } while (0)
#define G_LDB(dst, b, h) do { _Pragma("unroll") for (int n = 0; n < 2; ++n) _Pragma("unroll") for (int k = 0; k < 2; ++k) dst[n][k] = *(const LAS bf16x8*)(lds + G_SB(b, h) + boff + n * 2048 + k * 1024); } while (0)
#define G_MMA(ai, bj, At, Bt_) do { __builtin_amdgcn_s_setprio(1); _Pragma("unroll") for (int m = 0; m < 4; ++m) _Pragma("unroll") for (int n = 0; n < 2; ++n) _Pragma("unroll") for (int k = 0; k < 2; ++k) \
        acc[ai][bj][m][n] = __builtin_amdgcn_mfma_f32_16x16x32_bf16(Bt_[n][k], At[m][k], acc[ai][bj][m][n], 0, 0, 0); __builtin_amdgcn_s_setprio(0); } while (0)
#define G_WAIT_V(n) asm volatile("s_waitcnt vmcnt(" #n ")" ::: "memory")
#define G_WAIT_L(n) asm volatile("s_waitcnt lgkmcnt(" #n ")" ::: "memory")
#define G_BAR __builtin_amdgcn_s_barrier()
#define G_SCHED __builtin_amdgcn_sched_barrier(0)
    Unit cur, nxt; int ui = 0;
    if (!S.next(0, cur)) return;
    f32x4 acc[2][2][4][2];
#pragma unroll
    for (int a = 0; a < 2; ++a)
#pragma unroll
        for (int b = 0; b < 2; ++b)
#pragma unroll
            for (int m = 0; m < 4; ++m)
#pragma unroll
                for (int n = 0; n < 2; ++n) acc[a][b][m][n] = (f32x4){0.f, 0.f, 0.f, 0.f};
    bf16x8 At[4][2], B0[2][2], B1[2][2];
    const char* cA = (const char*)A + (size_t)cur.pm * tstep; const char* cB = (const char*)Bt + (size_t)cur.pn * tstep;
    G_STAGE(G_SB(0, 0), cB, voffB); G_STAGE(G_SA(0, 0), cA, voffA); G_STAGE(G_SB(0, 1), cB + hstep, voffB); G_STAGE(G_SA(0, 1), cA + hstep, voffA);
    if (wr == 1) G_BAR;
    G_WAIT_V(4); G_BAR;
    G_STAGE(G_SB(1, 0), cB + kstep, voffB); G_STAGE(G_SA(1, 0), cA + kstep, voffA); G_STAGE(G_SB(1, 1), cB + hstep + kstep, voffB);
    G_WAIT_V(6); G_BAR;
    for (;;) {
        const bool has_next = S.next(ui + 1, nxt);
        const char* nA = has_next ? (const char*)A + (size_t)nxt.pm * tstep : cA; const char* nB = has_next ? (const char*)Bt + (size_t)nxt.pn * tstep : cB;
        for (int t = 0; t < nt; t += 2) {
            const bool last = (t == nt - 2);
            const char* a1 = cA + (size_t)(t + 1) * kstep;
            const char* a2 = last ? nA : cA + (size_t)(t + 2) * kstep; const char* b2 = last ? nB : cB + (size_t)(t + 2) * kstep;
            const char* a3 = a2 + kstep; const char* b3 = b2 + kstep;
            G_LDB(B0, 0, 0); G_SCHED; G_LDA(At, 0, 0); G_STAGE(G_SA(1, 1), a1 + hstep, voffA);
            G_WAIT_L(8); G_BAR; G_WAIT_L(0); G_MMA(0, 0, At, B0); G_BAR; G_SCHED;
            G_LDB(B1, 0, 1); G_STAGE(G_SB(0, 0), b2, voffB);
            G_BAR; G_WAIT_L(0); G_MMA(0, 1, At, B1); G_BAR;
            G_LDA(At, 0, 1); G_STAGE(G_SA(0, 0), a2, voffA);
            G_BAR; G_WAIT_L(0); G_MMA(1, 0, At, B0); G_BAR; G_SCHED;
            G_STAGE(G_SB(0, 1), b2 + hstep, voffB);
            G_WAIT_V(6); G_BAR; G_MMA(1, 1, At, B1); G_BAR;
            G_LDB(B0, 1, 0); G_SCHED; G_LDA(At, 1, 0); G_STAGE(G_SA(0, 1), a2 + hstep, voffA);
            G_WAIT_L(8); G_BAR; G_WAIT_L(0); G_MMA(0, 0, At, B0); G_BAR; G_SCHED;
            G_LDB(B1, 1, 1); G_STAGE(G_SB(1, 0), b3, voffB);
            G_BAR; G_WAIT_L(0); G_MMA(0, 1, At, B1); G_BAR;
            G_LDA(At, 1, 1); G_STAGE(G_SA(1, 0), a3, voffA);
            G_BAR; G_WAIT_L(0); G_MMA(1, 0, At, B0); G_BAR; G_SCHED;
            G_STAGE(G_SB(1, 1), b3 + hstep, voffB);
            G_WAIT_V(6); G_BAR; G_MMA(1, 1, At, B1); G_BAR;
        }
        if constexpr (!Epi::AFTER_DRAIN) E(acc, cur.pm, cur.pn, wr, wc, fr, fq);
        if (!has_next) break;
#pragma unroll
        for (int a = 0; a < 2; ++a)
#pragma unroll
            for (int b = 0; b < 2; ++b)
#pragma unroll
                for (int m = 0; m < 4; ++m)
#pragma unroll
                    for (int n = 0; n < 2; ++n) acc[a][b][m][n] = (f32x4){0.f, 0.f, 0.f, 0.f};
        cur = nxt; cA = nA; cB = nB; ++ui;
    }
    G_WAIT_V(0);
    if (wr == 0) G_BAR;
    G_BAR;
    if constexpr (Epi::AFTER_DRAIN) E.fused(acc, cur.pm, cur.pn, wr, wc, fr, fq, lds);
#undef G_SA
#undef G_SB
#undef G_STAGE
#undef G_LDA
#undef G_LDB
#undef G_MMA
#undef G_WAIT_V
#undef G_WAIT_L
#undef G_BAR
#undef G_SCHED
}

typedef f32x4 AccT[2][2][4][2];

struct EpiHgrn {
    static constexpr bool PERM = true, AFTER_DRAIN = false;
    bf16_t* q; float* lf; bf16_t* v; bf16_t* sg; const float* lb;
    __device__ __forceinline__ void operator()(const AccT& acc, int pm, int pn, int wr, int wc, int fr, int fq) const {
        const int sec = pn >> 2;
        const int row0 = pm * 256 + wr * 64 + fr, cs0 = (pn & 3) * 256 + wc * 32 + 8 * fq;
        f32x4 l0[2], l1[2];
        if (sec == 1) {
#pragma unroll
            for (int bj = 0; bj < 2; ++bj) { l0[bj] = *(const f32x4*)(lb + cs0 + bj * 128); l1[bj] = *(const f32x4*)(lb + cs0 + bj * 128 + 4); }
        }
#pragma unroll
        for (int ai = 0; ai < 2; ++ai)
#pragma unroll
            for (int m = 0; m < 4; ++m) {
                const size_t ro = (size_t)(row0 + ai * 128 + m * 16) * DM;
#pragma unroll
                for (int bj = 0; bj < 2; ++bj) {
                    f32x4 v0 = acc[ai][bj][m][0], v1 = acc[ai][bj][m][1];
                    const size_t o = ro + cs0 + bj * 128;
                    if (sec == 1) {
#pragma unroll
                        for (int j = 0; j < 4; ++j) {
                            v0[j] = l0[bj][j] + (1.0f - l0[bj][j]) * sigmoidf_(v0[j]);
                            v1[j] = l1[bj][j] + (1.0f - l1[bj][j]) * sigmoidf_(v1[j]);
                        }
                        *(f32x4*)(lf + o) = v0; *(f32x4*)(lf + o + 4) = v1;
                    } else if (sec == 2) {
                        *(u32x4*)(v + o) = pack8(v0, v1);
                    } else {
#pragma unroll
                        for (int j = 0; j < 4; ++j) { v0[j] = siluf_(v0[j]); v1[j] = siluf_(v1[j]); }
                        *(u32x4*)((sec == 0 ? q : sg) + o) = pack8(v0, v1);
                    }
                }
            }
    }
};

struct EpiMoba {
    static constexpr bool PERM = true, AFTER_DRAIN = false;
    bf16_t *q, *k, *v, *sg; const float* rope; float* kmean;
    __device__ __forceinline__ void operator()(const AccT& acc, int pm, int pn, int wr, int wc, int fr, int fq) const {
        const int sec = pn >> 2;
        const int row0 = pm * 256 + wr * 64 + fr, cs0 = (pn & 3) * 256 + wc * 32 + 8 * fq;
        if (sec < 2) {
            const int d0 = 16 * wc + 4 * fq;
            bf16_t* dst = sec == 0 ? q : k;
            const float sc = sec == 0 ? 0.08838834764831845f * 1.4426950408889634f : 1.0f;
            f32x4 ks1[2], ks2[2];
#pragma unroll
            for (int bj = 0; bj < 2; ++bj) { ks1[bj] = (f32x4){0.f, 0.f, 0.f, 0.f}; ks2[bj] = (f32x4){0.f, 0.f, 0.f, 0.f}; }
            const int odd = fq & 1;
#pragma unroll
            for (int ai = 0; ai < 2; ++ai)
#pragma unroll
                for (int m = 0; m < 4; ++m) {
                    const int row = row0 + ai * 128 + m * 16; const int pos = row & (SEQ - 1);
                    const f32x4 cs = *(const f32x4*)(rope + pos * 64 + d0), sn = *(const f32x4*)(rope + SEQ * 64 + pos * 64 + d0);
#pragma unroll
                    for (int bj = 0; bj < 2; ++bj) {
                        const int head = (pn & 3) * 2 + bj;
                        const f32x4 v0 = acc[ai][bj][m][0], v1 = acc[ai][bj][m][1];
                        const f32x4 t1 = (f32x4){v0[0], v0[2], v1[0], v1[2]}, t2 = (f32x4){v0[1], v0[3], v1[1], v1[3]};
                        const f32x4 o1 = (t1 * cs - t2 * sn) * sc, o2 = (t2 * cs + t1 * sn) * sc;
                        if (sec == 1) { ks1[bj] += o1; ks2[bj] += o2; }
                        const u32x2 pa = pack4(o1), pb = pack4(o2);
                        const auto sx = __builtin_amdgcn_permlane16_swap(pa.x, pb.x, false, false);
                        const auto sy = __builtin_amdgcn_permlane16_swap(pa.y, pb.y, false, false);
                        *(u32x4*)(dst + (size_t)row * DM + head * 128 + (d0 - 4 * odd) + 64 * odd) = (u32x4){sx[0], sy[0], sx[1], sy[1]};
                    }
                }
            if (sec == 1) {
#pragma unroll
                for (int bj = 0; bj < 2; ++bj) {
                    const int head = (pn & 3) * 2 + bj;
#pragma unroll
                    for (int j = 0; j < 4; ++j) {
                        float a = ks1[bj][j], b = ks2[bj][j];
#pragma unroll
                        for (int o = 1; o < 16; o <<= 1) { a += __shfl_xor(a, o); b += __shfl_xor(b, o); }
                        ks1[bj][j] = a; ks2[bj][j] = b;
                    }
                    if (fr == 0) {
                        float* kp = kmean + (size_t)(((pm >> 3) * 8 + head) * 8 + (pm & 7)) * 128 + d0;
#pragma unroll
                        for (int j = 0; j < 4; ++j) { atomicAdd(kp + j, ks1[bj][j] * (1.0f / 256.0f)); atomicAdd(kp + 64 + j, ks2[bj][j] * (1.0f / 256.0f)); }
                    }
                }
            }
        } else if (sec == 2) {
#pragma unroll
            for (int ai = 0; ai < 2; ++ai)
#pragma unroll
                for (int m = 0; m < 4; ++m) {
                    const int row = row0 + ai * 128 + m * 16; const int bb = row >> 11, ss = row & (SEQ - 1);
#pragma unroll
                    for (int bj = 0; bj < 2; ++bj) {
                        const f32x4 v0 = acc[ai][bj][m][0], v1 = acc[ai][bj][m][1];
                        const int head = (pn & 3) * 2 + bj;
                        bf16_t* vp = v + ((size_t)((bb * 8 + head) * 128 + wc * 32 + 8 * fq)) * SEQ + ss;
                        const u32x4 pw = pack8(v0, v1);
                        vp[0] = (bf16_t)(pw.x & 0xffffu); vp[SEQ] = (bf16_t)(pw.x >> 16); vp[2 * SEQ] = (bf16_t)(pw.y & 0xffffu); vp[3 * SEQ] = (bf16_t)(pw.y >> 16);
                        vp[4 * SEQ] = (bf16_t)(pw.z & 0xffffu); vp[5 * SEQ] = (bf16_t)(pw.z >> 16); vp[6 * SEQ] = (bf16_t)(pw.w & 0xffffu); vp[7 * SEQ] = (bf16_t)(pw.w >> 16);
                    }
                }
        } else {
#pragma unroll
            for (int ai = 0; ai < 2; ++ai)
#pragma unroll
                for (int m = 0; m < 4; ++m) {
                    const size_t ro = (size_t)(row0 + ai * 128 + m * 16) * DM;
#pragma unroll
                    for (int bj = 0; bj < 2; ++bj) {
                        f32x4 v0 = acc[ai][bj][m][0], v1 = acc[ai][bj][m][1];
                        const size_t o = ro + cs0 + bj * 128;
#pragma unroll
                        for (int j = 0; j < 4; ++j) { v0[j] = siluf_(v0[j]); v1[j] = siluf_(v1[j]); }
                        *(u32x4*)(sg + o) = pack8(v0, v1);
                    }
                }
        }
    }
};

struct EpiS5 {
    static constexpr bool PERM = true, AFTER_DRAIN = false;
    bf16_t *u, *sg;
    __device__ __forceinline__ void operator()(const AccT& acc, int pm, int pn, int wr, int wc, int fr, int fq) const {
        const int sec = pn >> 2;
        const int row0 = pm * 256 + wr * 64 + fr, cs0 = (pn & 3) * 256 + wc * 32 + 8 * fq;
#pragma unroll
        for (int ai = 0; ai < 2; ++ai)
#pragma unroll
            for (int m = 0; m < 4; ++m) {
                const size_t ro = (size_t)(row0 + ai * 128 + m * 16) * DM;
#pragma unroll
                for (int bj = 0; bj < 2; ++bj) {
                    f32x4 v0 = acc[ai][bj][m][0], v1 = acc[ai][bj][m][1];
                    const size_t o = ro + cs0 + bj * 128;
                    if (sec == 1) {
#pragma unroll
                        for (int j = 0; j < 4; ++j) { v0[j] = siluf_(v0[j]); v1[j] = siluf_(v1[j]); }
                        *(u32x4*)(sg + o) = pack8(v0, v1);
                    } else {
                        const int row = row0 + ai * 128 + m * 16, cc = cs0 + bj * 128;
                        *(u32x4*)(u + ((size_t)((cc >> 4) * 16 + (row >> 11)) * SEQ + (row & (SEQ - 1))) * 16 + (cc & 8)) = pack8(v0, v1);
                    }
                }
            }
    }
};

struct EpiGlu {
    static constexpr bool PERM = true, AFTER_DRAIN = false;
    const bf16_t *y, *sg; const float* bias; bf16_t* o;
    __device__ __forceinline__ void operator()(const AccT& acc, int pm, int pn, int wr, int wc, int fr, int fq) const {
        const int row0 = pm * 256 + wr * 64 + fr, cs0 = pn * 256 + wc * 32 + 8 * fq;
        f32x4 b0[2], b1[2];
#pragma unroll
        for (int bj = 0; bj < 2; ++bj) { b0[bj] = *(const f32x4*)(bias + cs0 + bj * 128); b1[bj] = *(const f32x4*)(bias + cs0 + bj * 128 + 4); }
#pragma unroll
        for (int ai = 0; ai < 2; ++ai)
#pragma unroll
            for (int m = 0; m < 4; ++m) {
                const size_t ro = (size_t)(row0 + ai * 128 + m * 16) * DM;
#pragma unroll
                for (int bj = 0; bj < 2; ++bj) {
                    const size_t off = ro + cs0 + bj * 128;
                    const f32x4 z0 = acc[ai][bj][m][0] + b0[bj], z1 = acc[ai][bj][m][1] + b1[bj];
                    const u32x4 yv = *(const u32x4*)(y + off), gv = *(const u32x4*)(sg + off);
                    f32x4 r0, r1;
                    r0[0] = blo(yv.x) * sigmoidf_(z0[0]) * blo(gv.x); r0[1] = bhi(yv.x) * sigmoidf_(z0[1]) * bhi(gv.x);
                    r0[2] = blo(yv.y) * sigmoidf_(z0[2]) * blo(gv.y); r0[3] = bhi(yv.y) * sigmoidf_(z0[3]) * bhi(gv.y);
                    r1[0] = blo(yv.z) * sigmoidf_(z1[0]) * blo(gv.z); r1[1] = bhi(yv.z) * sigmoidf_(z1[1]) * bhi(gv.z);
                    r1[2] = blo(yv.w) * sigmoidf_(z1[2]) * blo(gv.w); r1[3] = bhi(yv.w) * sigmoidf_(z1[3]) * bhi(gv.w);
                    *(u32x4*)(o + off) = pack8(r0, r1);
                }
            }
    }
};

struct EpiOut {
    static constexpr bool PERM = false, AFTER_DRAIN = false;
    const float* res; float* t; int use_acc;
    __device__ __forceinline__ void operator()(const AccT& acc, int pm, int pn, int wr, int wc, int fr, int fq) const {
        const int row0 = pm * 256 + wr * 64 + fr, col0 = pn * 256 + wc * 32 + 4 * fq;
#pragma unroll
        for (int ai = 0; ai < 2; ++ai)
#pragma unroll
            for (int m = 0; m < 4; ++m) {
                const size_t ro = (size_t)(row0 + ai * 128 + m * 16) * DM + col0;
#pragma unroll
                for (int bj = 0; bj < 2; ++bj)
#pragma unroll
                    for (int n = 0; n < 2; ++n) {
                        const size_t off = ro + bj * 128 + n * 16;
                        const f32x4 r = *(const f32x4*)(res + off);
                        f32x4 a = acc[ai][bj][m][n]; if (!use_acc) a = (f32x4){0.f, 0.f, 0.f, 0.f};
                        *(f32x4*)(t + off) = r * ALPHA + a;
                    }
            }
    }
};


struct EpiOutLn {
    static constexpr bool PERM = false, AFTER_DRAIN = true;
    const float* res; float* dst; bf16_t* xb; const float* g; const float* bb; float* X; unsigned* cnt; int pm_off, use_acc, last;
    __device__ __forceinline__ void operator()(const AccT&, int, int, int, int, int, int) const {}
    __device__ __forceinline__ void fused(AccT& acc, int pm, int pn, int wr, int wc, int fr, int fq, LAS unsigned char* lds) const {
        const int tid = threadIdx.x;
        LAS float* part = (LAS float*)(lds + 131072);
        LAS float* stat = (LAS float*)(lds + 131072 + 8192);
        const int gpm = pm_off + pm;
        const int row0 = gpm * 256 + wr * 64 + fr, col0 = pn * 256 + wc * 32 + 4 * fq;
#pragma unroll
        for (int ai = 0; ai < 2; ++ai)
#pragma unroll
            for (int m = 0; m < 4; ++m) {
                const size_t ro = (size_t)(row0 + ai * 128 + m * 16) * DM + col0;
                float s1 = 0.f, s2 = 0.f;
#pragma unroll
                for (int bj = 0; bj < 2; ++bj)
#pragma unroll
                    for (int n = 0; n < 2; ++n) {
                        const f32x4 r = *(const f32x4*)(res + ro + bj * 128 + n * 16);
                        f32x4 t = r * ALPHA; if (use_acc) t += acc[ai][bj][m][n];
                        acc[ai][bj][m][n] = t;
                        s1 += (t[0] + t[1]) + (t[2] + t[3]); s2 += (t[0] * t[0] + t[1] * t[1]) + (t[2] * t[2] + t[3] * t[3]);
                    }
                s1 += __shfl_xor(s1, 16); s1 += __shfl_xor(s1, 32); s2 += __shfl_xor(s2, 16); s2 += __shfl_xor(s2, 32);
                if (fq == 0) { const int rl = ai * 128 + wr * 64 + m * 16 + fr; part[(rl * 4 + wc) * 2] = s1; part[(rl * 4 + wc) * 2 + 1] = s2; }
            }
        __syncthreads();
        if (tid < 256) {
            const float S = (part[(tid * 4 + 0) * 2] + part[(tid * 4 + 1) * 2]) + (part[(tid * 4 + 2) * 2] + part[(tid * 4 + 3) * 2]);
            const float Q = (part[(tid * 4 + 0) * 2 + 1] + part[(tid * 4 + 1) * 2 + 1]) + (part[(tid * 4 + 2) * 2 + 1] + part[(tid * 4 + 3) * 2 + 1]);
            unsigned long long* xq = (unsigned long long*)X + (size_t)(gpm * 4) * 256 + tid;
            __hip_atomic_store(xq + pn * 256, ((unsigned long long)__float_as_uint(Q) << 32) | (unsigned long long)__float_as_uint(S), __ATOMIC_RELAXED, __HIP_MEMORY_SCOPE_AGENT);
            float St = 0.f, Qt = 0.f;
#pragma unroll
            for (int p2 = 0; p2 < 4; ++p2) {
                unsigned long long wv; unsigned it = 0;
                while ((wv = __hip_atomic_load(xq + p2 * 256, __ATOMIC_RELAXED, __HIP_MEMORY_SCOPE_AGENT)) == ~0ull && ++it < (1u << 22)) __builtin_amdgcn_s_sleep(1);
                St += __uint_as_float((unsigned)wv); Qt += __uint_as_float((unsigned)(wv >> 32));
            }
            const float mean = St * (1.0f / 1024.0f); const float var = fmaxf(Qt * (1.0f / 1024.0f) - mean * mean, 0.f);
            stat[tid * 2] = mean; stat[tid * 2 + 1] = 1.0f / sqrtf(var + 1e-5f);
        }
        __syncthreads();
        f32x4 gq[2][2], bq4[2][2];
#pragma unroll
        for (int bj = 0; bj < 2; ++bj)
#pragma unroll
            for (int n = 0; n < 2; ++n) { gq[bj][n] = *(const f32x4*)(g + col0 + bj * 128 + n * 16); bq4[bj][n] = *(const f32x4*)(bb + col0 + bj * 128 + n * 16); }
#pragma unroll
        for (int ai = 0; ai < 2; ++ai)
#pragma unroll
            for (int m = 0; m < 4; ++m) {
                const int rl = ai * 128 + wr * 64 + m * 16 + fr;
                const float mean = stat[rl * 2], rstd = stat[rl * 2 + 1];
                const size_t ro = (size_t)(row0 + ai * 128 + m * 16) * DM + col0;
#pragma unroll
                for (int bj = 0; bj < 2; ++bj) {
                    u32x2 yb[2];
#pragma unroll
                    for (int n = 0; n < 2; ++n) {
                        const f32x4 y = (acc[ai][bj][m][n] - mean) * rstd * gq[bj][n] + bq4[bj][n];
                        *(f32x4*)(dst + ro + bj * 128 + n * 16) = y;
                        yb[n] = pack4(y);
                    }
                    if (!last) {
                        const auto sx = __builtin_amdgcn_permlane16_swap(yb[0].x, yb[1].x, false, false);
                        const auto sy = __builtin_amdgcn_permlane16_swap(yb[0].y, yb[1].y, false, false);
                        const int odd = fq & 1;
                        *(u32x4*)(xb + ro - 4 * fq + 4 * (fq & 2) + bj * 128 + odd * 16) = (u32x4){sx[0], sy[0], sx[1], sy[1]};
                    }
                }
            }
        __syncthreads();
    }
};

__device__ __forceinline__ void transpose_w(const float* w, int N, bf16_t* wt, int moba, int gw, int nw, int lane) {
    const int nbn = N >> 3, nitems = nbn * 16;
    const int nl = lane & 7, kl = lane >> 3;
    for (int it = gw; it < nitems; it += nw) {
        const int nb = it % nbn, kb = it / nbn;
        const int n = nb * 8 + nl, k0 = kb * 64 + kl * 8;
        float f[8];
#pragma unroll
        for (int i = 0; i < 8; ++i) f[i] = w[(size_t)(k0 + i) * N + n];
        int np = n;
        if (moba && n < 2048) { const int d = n & 127; np = (n & ~127) + ((d & 63) << 1) + (d >> 6); }
        u32x4 o; o.x = pk(f[0], f[1]); o.y = pk(f[2], f[3]); o.z = pk(f[4], f[5]); o.w = pk(f[6], f[7]);
        *(u32x4*)(wt + (size_t)np * 1024 + k0) = o;
    }
}

__device__ __forceinline__ void s5_setup(const P& p, int g, LAS unsigned char* lds) {
    LAS float* apr = (LAS float*)lds;
    LAS float* api = apr + 17 * 64;
    LAS float* bbr = api + 17 * 64;
    LAS float* bbi = bbr + 1024;
    LAS float* ccr = bbi + 1024;
    LAS float* cci = ccr + 1024;
    LAS float* Kt = cci + 1024;
    const int tid = threadIdx.x;
    __syncthreads();
    if (tid < 64) {
        const int pp = tid;
        const float dt = expf(p.log_dt[g]);
        const float ar = p.a_re[g * 64 + pp], ai = p.a_im[g * 64 + pp];
        const float mag = expf(dt * ar); const float th = dt * ai;
        const float abr = mag * cosf(th), abi = mag * sinf(th);
        const float nr = abr - 1.0f, ni = abi, den = ar * ar + ai * ai;
        const float zr = (nr * ar + ni * ai) / den, zi = (ni * ar - nr * ai) / den;
        for (int h = 0; h < 16; ++h) {
            const float br = p.b_re[(size_t)(g * 64 + pp) * 16 + h], bi = p.b_im[(size_t)(g * 64 + pp) * 16 + h];
            bbr[pp * 16 + h] = zr * br - zi * bi; bbi[pp * 16 + h] = zr * bi + zi * br;
        }
        float pr = 1.0f, pi = 0.0f;
        for (int t = 0; t <= 16; ++t) { apr[t * 64 + pp] = pr; api[t * 64 + pp] = pi; const float nr2 = pr * abr - pi * abi, ni2 = pr * abi + pi * abr; pr = nr2; pi = ni2; }
        p.a16[(g * 64 + pp) * 2] = apr[16 * 64 + pp]; p.a16[(g * 64 + pp) * 2 + 1] = api[16 * 64 + pp];
    }
    for (int i = tid; i < 1024; i += 512) { ccr[i] = p.c_re[(size_t)g * 1024 + i]; cci[i] = p.c_im[(size_t)g * 1024 + i]; }
    __syncthreads();
    for (int e = tid; e < 4096; e += 512) {
        const int tau = e >> 8, hp = (e >> 4) & 15, h = e & 15;
        float s = 0.f;
        for (int pp = 0; pp < 64; ++pp) {
            const float cr = ccr[hp * 64 + pp], ci = cci[hp * 64 + pp], pr = apr[tau * 64 + pp], pi = api[tau * 64 + pp];
            const float car = cr * pr - ci * pi, cai = cr * pi + ci * pr;
            s += car * bbr[pp * 16 + h] - cai * bbi[pp * 16 + h];
        }
        Kt[e] = s;
    }
    __syncthreads();
    bf16_t* W1 = p.s5w1 + (size_t)g * 32768; bf16_t* T = p.s5t + (size_t)g * 65536; bf16_t* W2 = p.s5w2 + (size_t)g * 32768;
    for (int e = tid; e < 32768; e += 512) {
        const int n = e >> 8, kk = e & 255, j = kk >> 4, h = kk & 15, pp = n & 63;
        const float pr = apr[(15 - j) * 64 + pp], pi = api[(15 - j) * 64 + pp], br = bbr[pp * 16 + h], bi = bbi[pp * 16 + h];
        W1[e] = f2bf(n < 64 ? pr * br - pi * bi : pr * bi + pi * br);
    }
    for (int e = tid; e < 65536; e += 512) {
        const int n = e >> 8, kk = e & 255, j = n >> 4, hp = n & 15, j2 = kk >> 4, h = kk & 15;
        T[e] = f2bf(j2 <= j ? Kt[(j - j2) * 256 + hp * 16 + h] : 0.0f);
    }
    for (int e = tid; e < 32768; e += 512) {
        const int n = e >> 7, kk = e & 127, j = n >> 4, hp = n & 15, pp = kk & 63;
        const float pr = apr[(j + 1) * 64 + pp], pi = api[(j + 1) * 64 + pp], cr = ccr[hp * 64 + pp], ci = cci[hp * 64 + pp];
        W2[e] = f2bf(kk < 64 ? cr * pr - ci * pi : -(cr * pi + ci * pr));
    }
    __syncthreads();
}

__device__ __forceinline__ void prologue(const P& p, LAS unsigned char* lds) {
    const int tid = threadIdx.x, lane = tid & 63;
    const int gw = blockIdx.x * 8 + (tid >> 6), nw = gridDim.x * 8;
    const int gt = blockIdx.x * 512 + tid, ntot = gridDim.x * 512;
    for (int c = gt; c < 1024; c += ntot) {
        const float a0 = p.lbl[c], a1 = p.lbl[1024 + c], a2 = p.lbl[2048 + c], a3 = p.lbl[3072 + c];
        const float mx = fmaxf(fmaxf(a0, a1), fmaxf(a2, a3));
        const float e0 = expf(a0 - mx), e1 = expf(a1 - mx), e2 = expf(a2 - mx), e3 = expf(a3 - mx);
        const float inv = 1.0f / (e0 + e1 + e2 + e3);
        p.lb[c] = 0.0f; p.lb[1024 + c] = e1 * inv; p.lb[2048 + c] = (e1 + e2) * inv; p.lb[3072 + c] = (e1 + e2 + e3) * inv;
    }
    for (int e = gt; e < 16 * 8 * 8 * 128; e += ntot) p.kmean[e] = 0.0f;
    for (int e = gt; e < 512; e += ntot) p.lncnt[e] = 0u;
    for (int e = gt; e < 4 * 128 * 4 * 256; e += ntot) ((unsigned long long*)p.lnx)[e] = ~0ull;
    for (size_t e = (size_t)gt; e < (size_t)NTOK * DM / 8; e += ntot) {
        const f32x4 a = *(const f32x4*)(p.x + e * 8), b = *(const f32x4*)(p.x + e * 8 + 4);
        *(u32x4*)(p.xb + e * 8) = pack8(a, b);
    }
    transpose_w(p.w_in[0], 4096, p.wt_in[0], 0, gw, nw, lane);
    transpose_w(p.w_out[0], 1024, p.wt_out[0], 0, gw, nw, lane);
}
__device__ __forceinline__ void prologue_b(const P& p, int wg, int nwg, LAS unsigned char* lds) {
    const int tid = threadIdx.x, lane = tid & 63;
    const int gw = wg * 8 + (tid >> 6), nw = nwg * 8;
    const int gt = wg * 512 + tid, ntot = nwg * 512;
    for (int g = wg; g < 64; g += nwg) s5_setup(p, g, lds);
    for (int e = gt; e < SEQ * 64; e += ntot) {
        const int pos = e >> 6, i = e & 63;
        const float inv_freq = 1.0f / powf(10000.0f, (float)(2 * i) / 128.0f);
        const float ang = (float)pos * inv_freq;
        p.rope[e] = cosf(ang); p.rope[SEQ * 64 + e] = sinf(ang);
    }
    transpose_w(p.w_in[1], 4096, p.wt_in[1], 1, gw, nw, lane);
    transpose_w(p.w_in[2], 2048, p.wt_in[2], 0, gw, nw, lane);
    transpose_w(p.w_in[3], 4096, p.wt_in[3], 0, gw, nw, lane);
    for (int l = 1; l < 4; ++l) transpose_w(p.w_out[l], 1024, p.wt_out[l], 0, gw, nw, lane);
    transpose_w(p.w_glu, 1024, p.wt_glu, 0, gw, nw, lane);
}

__device__ __forceinline__ void ln_phase(const P& p, int layer) {
    const int tid = threadIdx.x, lane = tid & 63;
    const int gw = blockIdx.x * 8 + (tid >> 6), nw = gridDim.x * 8;
    const float* g = p.ln_g[layer]; const float* bb = p.ln_b[layer];
    f32x4 gv[4], bv[4];
#pragma unroll
    for (int r = 0; r < 4; ++r) { gv[r] = *(const f32x4*)(g + r * 256 + lane * 4); bv[r] = *(const f32x4*)(bb + r * 256 + lane * 4); }
    const bool last = layer == 3;
    float* dst = last ? p.out : p.xf;
    for (int row = gw; row < NTOK; row += nw) {
        const float* src = p.xf + (size_t)row * DM;
        f32x4 v[4];
#pragma unroll
        for (int r = 0; r < 4; ++r) v[r] = *(const f32x4*)(src + r * 256 + lane * 4);
        float s = 0.f;
#pragma unroll
        for (int r = 0; r < 4; ++r) s += v[r][0] + v[r][1] + v[r][2] + v[r][3];
#pragma unroll
        for (int o = 32; o >= 1; o >>= 1) s += __shfl_xor(s, o);
        const float mu = s * (1.0f / 1024.0f);
        float q = 0.f;
#pragma unroll
        for (int r = 0; r < 4; ++r) { v[r] = v[r] - mu; q += v[r][0] * v[r][0] + v[r][1] * v[r][1] + v[r][2] * v[r][2] + v[r][3] * v[r][3]; }
#pragma unroll
        for (int o = 32; o >= 1; o >>= 1) q += __shfl_xor(q, o);
        const float rstd = 1.0f / sqrtf(q * (1.0f / 1024.0f) + 1e-5f);
#pragma unroll
        for (int r = 0; r < 4; ++r) {
            const f32x4 y = v[r] * rstd * gv[r] + bv[r];
            *(f32x4*)(dst + (size_t)row * DM + r * 256 + lane * 4) = y;
            if (!last) *(u32x2*)(p.xb + (size_t)row * DM + r * 256 + lane * 4) = pack4(y);
        }
    }
}

__device__ __forceinline__ void hgrn_scan(const P& p, int layer, LAS unsigned char* lds) {
    const int tid = threadIdx.x, w = tid >> 6, lane = tid & 63, lr = lane & 15, lq = lane >> 4;
    LAS bf16_t* qd = (LAS bf16_t*)(lds);
    LAS bf16_t* kd = (LAS bf16_t*)(lds + 17408);
    LAS bf16_t* keT = (LAS bf16_t*)(lds + 34816);
    LAS bf16_t* vT = (LAS bf16_t*)(lds + 53248);
    LAS bf16_t* Pm = (LAS bf16_t*)(lds + 71680);
    LAS bf16_t* stT = (LAS bf16_t*)(lds + 80896);
    LAS float* qsum = (LAS float*)(lds + 115712);
    LAS float* dl = (LAS float*)(lds + 117760);
    LAS float* em = (LAS float*)(lds + 118272);
    LAS float* osm = (LAS float*)(lds + 118784);
    const float* fb = p.out;
    const bf16_t* qg = p.s[0]; const bf16_t* vg = p.s[2]; const bf16_t* sgg = p.s[3]; bf16_t* ab = p.xb;
    const int ek = tid & 127, etq = tid >> 7;
    const int vs = tid >> 3, vv0 = (tid & 7) * 16;
    for (int item = blockIdx.x; item < 128; item += gridDim.x) {
        const int b = item >> 3, h = item & 7;
        f32x4 st[8];
#pragma unroll
        for (int i = 0; i < 8; ++i) st[i] = (f32x4){0.f, 0.f, 0.f, 0.f};
        f32x4 ngv[4];
#pragma unroll
        for (int i = 0; i < 4; ++i) ngv[i] = *(const f32x4*)(p.norm_g[layer] + h * 128 + vv0 + i * 4);
        float fv[16]; bf16_t qv[16]; u32x4 vr0, vr1, gr0, gr1;
#define HG_LOAD(c_) do { const size_t _r0 = (size_t)b * SEQ + (c_) * 64; \
            _Pragma("unroll") for (int i = 0; i < 16; ++i) { const size_t o = (_r0 + etq * 16 + i) * DM + h * 128 + ek; fv[i] = fb[o]; qv[i] = qg[o]; } \
            const size_t _vo = (_r0 + vs) * DM + h * 128 + vv0; \
            vr0 = *(const u32x4*)(vg + _vo); vr1 = *(const u32x4*)(vg + _vo + 8); gr0 = *(const u32x4*)(sgg + _vo); gr1 = *(const u32x4*)(sgg + _vo + 8); } while (0)
        HG_LOAD(0);
        for (int c = 0; c < 32; ++c) {
            const size_t vo = ((size_t)b * SEQ + c * 64 + vs) * DM + h * 128 + vv0;
            float cp[16];
            {
                float run = 1.0f;
#pragma unroll
                for (int i = 0; i < 16; ++i) { run *= fv[i]; cp[i] = run; }
                qsum[etq * 128 + ek] = run;
            }
            __syncthreads();
            {
                const float q0 = qsum[ek], q1 = qsum[128 + ek], q2 = qsum[256 + ek], q3 = qsum[384 + ek];
                const float pre = etq == 0 ? 1.0f : (etq == 1 ? q0 : (etq == 2 ? q0 * q1 : q0 * q1 * q2));
                const float mref = q0 * q1, blast = mref * (q2 * q3);
                const float invm = 1.0f / mref;
                unsigned kev[8];
#pragma unroll
                for (int i = 0; i < 16; i += 2) {
                    float ke2[2];
#pragma unroll
                    for (int u = 0; u < 2; ++u) {
                        const float e = pre * cp[i + u];
                        const float inv = __builtin_amdgcn_rcpf(e);
                        const float kf = 1.0f - fv[i + u];
                        const int t = etq * 16 + i + u;
                        qd[t * 136 + ek] = f2bf(bf2f(qv[i + u]) * (e * invm));
                        kd[t * 136 + ek] = f2bf(kf * (mref * inv));
                        ke2[u] = kf * (blast * inv);
                    }
                    kev[i >> 1] = pk(ke2[0], ke2[1]);
                }
                *(LAS u32x4*)(keT + ek * 72 + etq * 16) = (u32x4){kev[0], kev[1], kev[2], kev[3]};
                *(LAS u32x4*)(keT + ek * 72 + etq * 16 + 8) = (u32x4){kev[4], kev[5], kev[6], kev[7]};
                if (etq == 0) { dl[ek] = blast; em[ek] = mref; }
                const unsigned vw[8] = {vr0.x, vr0.y, vr0.z, vr0.w, vr1.x, vr1.y, vr1.z, vr1.w};
#pragma unroll
                for (int e = 0; e < 8; ++e) { vT[(vv0 + 2 * e) * 72 + vs] = (bf16_t)(vw[e] & 0xffffu); vT[(vv0 + 2 * e + 1) * 72 + vs] = (bf16_t)(vw[e] >> 16); }
            }
            const u32x4 gc0 = gr0, gc1 = gr1;
            if (c + 1 < 32) HG_LOAD(c + 1);
            __syncthreads();
            {
                const f32x4 e4 = *(const LAS f32x4*)(em + w * 16 + 4 * lq);
#pragma unroll
                for (int vt = 0; vt < 8; ++vt) *(LAS u32x2*)(stT + (vt * 16 + lr) * 136 + w * 16 + 4 * lq) = pack4(st[vt] * e4);
            }
            {
                const int stile = w >> 1;
#pragma unroll
                for (int t2 = 0; t2 < 2; ++t2) {
                    const int ttile = (w & 1) * 2 + t2;
                    f32x4 a = (f32x4){0.f, 0.f, 0.f, 0.f};
                    if (stile <= ttile) {
#pragma unroll
                        for (int ks = 0; ks < 4; ++ks) {
                            const bf16x8 A = *(const LAS bf16x8*)(kd + (stile * 16 + lr) * 136 + ks * 32 + lq * 8);
                            const bf16x8 B = *(const LAS bf16x8*)(qd + (ttile * 16 + lr) * 136 + ks * 32 + lq * 8);
                            a = mfma16(A, B, a);
                        }
#pragma unroll
                        for (int i = 0; i < 4; ++i) if (stile * 16 + 4 * lq + i > ttile * 16 + lr) a[i] = 0.f;
                    }
                    *(LAS u32x2*)(Pm + (ttile * 16 + lr) * 72 + stile * 16 + 4 * lq) = pack4(a);
                }
            }
            __syncthreads();
            {
                bf16x8 av[2], as_[4];
#pragma unroll
                for (int ks = 0; ks < 2; ++ks) av[ks] = *(const LAS bf16x8*)(vT + (w * 16 + lr) * 72 + ks * 32 + lq * 8);
#pragma unroll
                for (int ks = 0; ks < 4; ++ks) as_[ks] = *(const LAS bf16x8*)(stT + (w * 16 + lr) * 136 + ks * 32 + lq * 8);
#pragma unroll
                for (int tt = 0; tt < 4; ++tt) {
                    f32x4 a = (f32x4){0.f, 0.f, 0.f, 0.f};
#pragma unroll
                    for (int ks = 0; ks < 2; ++ks) a = mfma16(av[ks], *(const LAS bf16x8*)(Pm + (tt * 16 + lr) * 72 + ks * 32 + lq * 8), a);
#pragma unroll
                    for (int ks = 0; ks < 4; ++ks) a = mfma16(as_[ks], *(const LAS bf16x8*)(qd + (tt * 16 + lr) * 136 + ks * 32 + lq * 8), a);
                    *(LAS f32x4*)(osm + (tt * 16 + lr) * 132 + w * 16 + 4 * lq) = a;
                }
            }
            {
                const f32x4 d4 = *(const LAS f32x4*)(dl + w * 16 + 4 * lq);
#pragma unroll
                for (int vt = 0; vt < 8; ++vt) st[vt] = st[vt] * d4;
#pragma unroll
                for (int ks = 0; ks < 2; ++ks) {
                    const bf16x8 A = *(const LAS bf16x8*)(keT + (w * 16 + lr) * 72 + ks * 32 + lq * 8);
#pragma unroll
                    for (int vt = 0; vt < 8; ++vt) st[vt] = mfma16(A, *(const LAS bf16x8*)(vT + (vt * 16 + lr) * 72 + ks * 32 + lq * 8), st[vt]);
                }
            }
            __syncthreads();
            {
                f32x4 x4[4];
#pragma unroll
                for (int i = 0; i < 4; ++i) x4[i] = *(const LAS f32x4*)(osm + vs * 132 + vv0 + i * 4);
                float ss = 0.f;
#pragma unroll
                for (int i = 0; i < 4; ++i) ss += x4[i][0] * x4[i][0] + x4[i][1] * x4[i][1] + x4[i][2] * x4[i][2] + x4[i][3] * x4[i][3];
                ss += __shfl_xor(ss, 1); ss += __shfl_xor(ss, 2); ss += __shfl_xor(ss, 4);
                const float rstd = 1.0f / sqrtf(ss * (1.0f / 128.0f) + 1e-6f);
                const unsigned gw_[8] = {gc0.x, gc0.y, gc0.z, gc0.w, gc1.x, gc1.y, gc1.z, gc1.w};
                unsigned ow[8];
#pragma unroll
                for (int i = 0; i < 4; ++i) {
                    const f32x4 y = x4[i] * rstd * ngv[i];
                    ow[2 * i] = pk(y[0] * blo(gw_[2 * i]), y[1] * bhi(gw_[2 * i]));
                    ow[2 * i + 1] = pk(y[2] * blo(gw_[2 * i + 1]), y[3] * bhi(gw_[2 * i + 1]));
                }
                *(u32x4*)(ab + vo) = (u32x4){ow[0], ow[1], ow[2], ow[3]};
                *(u32x4*)(ab + vo + 8) = (u32x4){ow[4], ow[5], ow[6], ow[7]};
            }
        }
#undef HG_LOAD
        __syncthreads();
    }
}

__device__ __forceinline__ void moba_block(const P& p, int b, int h, int n, LAS unsigned char* lds) {
    int tid = threadIdx.x; asm volatile("" : "+v"(tid));
    const int w = tid >> 6, lane = tid & 63, lr = lane & 15, lq = lane >> 4;
    LAS float* km = (LAS float*)lds;
    LAS bf16_t* ks_ = (LAS bf16_t*)(lds + 4096);
    LAS bf16_t* vT = (LAS bf16_t*)(lds + 4096 + 17408);
    const bf16_t* qg = p.s[0]; const bf16_t* kg = p.s[1]; const bf16_t* vg = p.s[2]; const bf16_t* sgg = p.s[3]; bf16_t* ab = p.xb;
    const size_t rowb = (size_t)b * SEQ;
    bf16x8 Qf[2][4];
#pragma unroll
    for (int qt = 0; qt < 2; ++qt)
#pragma unroll
        for (int kx = 0; kx < 4; ++kx) Qf[qt][kx] = *(const bf16x8*)(qg + (rowb + n * 256 + w * 32 + qt * 16 + lr) * DM + h * 128 + kx * 32 + lq * 8);
    const int ntiles = (n + 1) * 4;
    const bf16_t* vtg = vg + (size_t)((b * 8 + h) * 128) * SEQ;
    u32x4 pk_[2], pv_[2];
#define MB_LOAD(ti) do { const int _blk = (ti) >> 2; const int _j = _blk == 0 ? n : _blk - 1; const size_t _kb = (size_t)_j * 256 + ((ti) & 3) * 64; \
        _Pragma("unroll") for (int r = 0; r < 2; ++r) { const int ci = tid + 512 * r; \
            pk_[r] = *(const u32x4*)(kg + (rowb + _kb + (ci >> 4)) * DM + h * 128 + (ci & 15) * 8); \
            pv_[r] = *(const u32x4*)(vtg + (size_t)(ci >> 3) * SEQ + _kb + (ci & 7) * 8); } } while (0)
#define MB_STORE(bufi) do { LAS bf16_t* _ks = ks_ + (bufi) * 32768; LAS bf16_t* _vt = _ks + 64 * 136; \
        _Pragma("unroll") for (int r = 0; r < 2; ++r) { const int ci = tid + 512 * r; \
            *(LAS u32x4*)(_ks + (ci >> 4) * 136 + (ci & 15) * 8) = pk_[r]; *(LAS u32x4*)(_vt + (ci >> 3) * 72 + (ci & 7) * 8) = pv_[r]; } } while (0)
    u32x4 pk2[2], pv2[2];
    MB_LOAD(0);
    pk2[0] = pk_[0]; pk2[1] = pk_[1]; pv2[0] = pv_[0]; pv2[1] = pv_[1];
    MB_LOAD(1);
    float kmv[2];
#pragma unroll
    for (int r = 0; r < 2; ++r) kmv[r] = (tid + 512 * r < n * 128) ? p.kmean[(size_t)((b * 8 + h) * 8) * 128 + tid + 512 * r] : 0.f;
    __syncthreads();
    LAS bf16_t* km16 = (LAS bf16_t*)lds;
#pragma unroll
    for (int r = 0; r < 2; ++r) if (tid + 512 * r < n * 128) km16[tid + 512 * r] = f2bf(kmv[r]);
    __syncthreads();
    unsigned sel[2];
#pragma unroll
    for (int qt = 0; qt < 2; ++qt) {
        f32x4 gacc = (f32x4){0.f, 0.f, 0.f, 0.f};
#pragma unroll
        for (int kx = 0; kx < 4; ++kx) gacc = mfma16(*(const LAS bf16x8*)(km16 + lr * 128 + kx * 32 + lq * 8), Qf[qt][kx], gacc);
        float g[7];
        g[0] = gacc[0]; g[1] = gacc[1]; g[2] = gacc[2]; g[3] = gacc[3];
        g[4] = __shfl(gacc[0], lr + 16); g[5] = __shfl(gacc[1], lr + 16); g[6] = __shfl(gacc[2], lr + 16);
        unsigned s = 0;
        if (n <= 3) s = (1u << n) - 1u;
        else {
#pragma unroll
            for (int r = 0; r < 3; ++r) {
                float best = -3.0e38f; int bi = 0;
#pragma unroll
                for (int j = 0; j < 7; ++j) if (j < n && !((s >> j) & 1u) && g[j] > best) { best = g[j]; bi = j; }
                s |= 1u << bi;
            }
        }
        sel[qt] = __shfl(s, lr);
    }
    float mrow[2] = {-1e30f, -1e30f}, lrow[2] = {0.f, 0.f};
    f32x4 O[8][2];
#pragma unroll
    for (int dt = 0; dt < 8; ++dt) { O[dt][0] = (f32x4){0.f, 0.f, 0.f, 0.f}; O[dt][1] = (f32x4){0.f, 0.f, 0.f, 0.f}; }
    for (int ti = 0; ti < ntiles; ++ti) {
        const int blk = ti >> 2, tile = ti & 3;
        const int j = blk == 0 ? n : blk - 1; const bool own = blk == 0;
        if ((ti & 1) == 0) {
            __syncthreads();
            { LAS bf16_t* _ks = ks_; LAS bf16_t* _vt = _ks + 64 * 136;
#pragma unroll
              for (int r = 0; r < 2; ++r) { const int ci = tid + 512 * r;
                *(LAS u32x4*)(_ks + (ci >> 4) * 136 + (ci & 15) * 8) = pk2[r]; *(LAS u32x4*)(_vt + (ci >> 3) * 72 + (ci & 7) * 8) = pv2[r]; } }
            MB_STORE(1);
            __syncthreads();
            if (ti + 2 < ntiles) {
                MB_LOAD(ti + 2);
                pk2[0] = pk_[0]; pk2[1] = pk_[1]; pv2[0] = pv_[0]; pv2[1] = pv_[1];
                MB_LOAD(ti + 3);
            }
        }
        const LAS bf16_t* kbuf = ks_ + (ti & 1) * 32768; const LAS bf16_t* vbuf = kbuf + 64 * 136;
        const bool lane_need = (((sel[0] | sel[1]) >> j) & 1u) != 0;
        const bool need = own ? (tile * 64 <= w * 32 + 31) : (__ballot(lane_need) != 0ull);
        if (need) {
            f32x4 sT[4][2];
#pragma unroll
            for (int kt = 0; kt < 4; ++kt) { sT[kt][0] = (f32x4){0.f, 0.f, 0.f, 0.f}; sT[kt][1] = (f32x4){0.f, 0.f, 0.f, 0.f}; }
#pragma unroll
            for (int kt = 0; kt < 4; ++kt)
#pragma unroll
                for (int kx = 0; kx < 4; ++kx) {
                    const bf16x8 A = *(const LAS bf16x8*)(kbuf + (kt * 16 + lr) * 136 + kx * 32 + lq * 8);
                    sT[kt][0] = mfma16(A, Qf[0][kx], sT[kt][0]); sT[kt][1] = mfma16(A, Qf[1][kx], sT[kt][1]);
                    if (kx == 3) __builtin_amdgcn_sched_barrier(0);
                }
            const bool diag = own && (tile * 64 + 63 > w * 32);
#pragma unroll
            for (int qt = 0; qt < 2; ++qt) {
                const int qq = w * 32 + qt * 16 + lr;
                const bool selj = own || (((sel[qt] >> j) & 1u) != 0);
                if (diag) {
#pragma unroll
                    for (int kt = 0; kt < 4; ++kt)
#pragma unroll
                        for (int i = 0; i < 4; ++i) { const int key = tile * 64 + kt * 16 + 4 * lq + i; sT[kt][qt][i] = key <= qq ? sT[kt][qt][i] : -1e30f; }
                }
                float mx = fmaxf(fmaxf(fmaxf(sT[0][qt][0], sT[0][qt][1]), fmaxf(sT[0][qt][2], sT[0][qt][3])), fmaxf(fmaxf(sT[1][qt][0], sT[1][qt][1]), fmaxf(sT[1][qt][2], sT[1][qt][3])));
                mx = fmaxf(mx, fmaxf(fmaxf(fmaxf(sT[2][qt][0], sT[2][qt][1]), fmaxf(sT[2][qt][2], sT[2][qt][3])), fmaxf(fmaxf(sT[3][qt][0], sT[3][qt][1]), fmaxf(sT[3][qt][2], sT[3][qt][3]))));
                mx = xmax_16_32(mx);
                const float cand = selj ? mx : -3.0e38f;
                float alpha = 1.0f;
                if (!__all(cand - mrow[qt] <= 8.0f)) {
                    const float mnew = fmaxf(mrow[qt], cand);
                    alpha = __builtin_amdgcn_exp2f(mrow[qt] - mnew);
                    mrow[qt] = mnew;
#pragma unroll
                    for (int dt = 0; dt < 8; ++dt) O[dt][qt] = O[dt][qt] * alpha;
                }
                const float msub = selj ? mrow[qt] : 1e30f;
                float ps = 0.f;
#pragma unroll
                for (int kt = 0; kt < 4; ++kt)
#pragma unroll
                    for (int i = 0; i < 4; ++i) { const float pv = __builtin_amdgcn_exp2f(sT[kt][qt][i] - msub); ps += pv; sT[kt][qt][i] = pv; }
                lrow[qt] = lrow[qt] * alpha + ps;
            }
#pragma unroll
            for (int kg2 = 0; kg2 < 2; ++kg2) {
                bf16x8 pf[2];
#pragma unroll
                for (int qt = 0; qt < 2; ++qt) {
                    const u32x4 pw = pack8(sT[2 * kg2][qt], sT[2 * kg2 + 1][qt]);
                    pf[qt] = __builtin_bit_cast(bf16x8, pw);
                }
#pragma unroll
                for (int dt = 0; dt < 8; ++dt) {
                    const u32x2 lo = *(const LAS u32x2*)(vbuf + (dt * 16 + lr) * 72 + kg2 * 32 + 4 * lq);
                    const u32x2 hi = *(const LAS u32x2*)(vbuf + (dt * 16 + lr) * 72 + kg2 * 32 + 16 + 4 * lq);
                    const u32x4 vw = (u32x4){lo.x, lo.y, hi.x, hi.y};
                    const bf16x8 vf = __builtin_bit_cast(bf16x8, vw);
                    O[dt][0] = mfma16(vf, pf[0], O[dt][0]); O[dt][1] = mfma16(vf, pf[1], O[dt][1]);
                    if (dt & 1) __builtin_amdgcn_sched_barrier(0);
                }
            }
        }
    }
#undef MB_LOAD
#undef MB_STORE
#pragma unroll
    for (int qt = 0; qt < 2; ++qt) {
        const float l = xsum_16_32(lrow[qt]);
        const float inv = 1.0f / l;
        const int odd = lq & 1;
        const size_t ro = (rowb + n * 256 + w * 32 + qt * 16 + lr) * DM + h * 128 + 4 * (lq & 2);
        u32x4 gg[4];
#pragma unroll
        for (int dp = 0; dp < 4; ++dp) gg[dp] = *(const u32x4*)(sgg + ro + (2 * dp + odd) * 16);
#pragma unroll
        for (int dp = 0; dp < 4; ++dp) {
            const f32x4 ya = O[2 * dp][qt] * inv, yb = O[2 * dp + 1][qt] * inv;
            f32x4 lo4, hi4;
#pragma unroll
            for (int i = 0; i < 4; ++i) {
                const auto sw = __builtin_amdgcn_permlane16_swap(__float_as_uint(ya[i]), __float_as_uint(yb[i]), false, false);
                lo4[i] = __uint_as_float(sw[0]); hi4[i] = __uint_as_float(sw[1]);
            }
            const u32x4 g = gg[dp];
            lo4[0] *= blo(g.x); lo4[1] *= bhi(g.x); lo4[2] *= blo(g.y); lo4[3] *= bhi(g.y);
            hi4[0] *= blo(g.z); hi4[1] *= bhi(g.z); hi4[2] *= blo(g.w); hi4[3] *= bhi(g.w);
            *(u32x4*)(ab + ro + (2 * dp + odd) * 16) = pack8(lo4, hi4);
        }
    }
}

__device__ __forceinline__ void moba_phase(const P& p, LAS unsigned char* lds) {
    for (int it = blockIdx.x; it < 512; it += gridDim.x) {
        const int pi = it & 3, bh = it >> 2, b = bh >> 3, h = bh & 7;
        for (int half = 0; half < 2; ++half) moba_block(p, b, h, half ? pi : 7 - pi, lds);
    }
}

__device__ __forceinline__ void s5_scan(const P& p, LAS unsigned char* lds) {
    LAS float* Es = (LAS float*)lds;
    LAS bf16_t* Tl = (LAS bf16_t*)lds;
    LAS bf16_t* Hp = (LAS bf16_t*)(lds + 67584);
    LAS float* wsum = (LAS float*)(lds + 102400);
    LAS bf16_t* SA = (LAS bf16_t*)(lds + 106496);
    for (int q = blockIdx.x; q < 256; q += gridDim.x)
    for (int bi = 0; bi < 4; ++bi) {
        int tid = threadIdx.x; asm volatile("" : "+v"(tid));
        const int w = tid >> 6, lane = tid & 63, lr = lane & 15, lq = lane >> 4;
        const int g = q >> 2, b = (q & 3) * 4 + bi;
        const bf16_t* u = p.s[0] + (size_t)(g * 16 + b) * SEQ * 16;
        bf16_t* yo = p.s[1] + (size_t)b * SEQ * DM + g * 16;
        const bf16_t* W1 = p.s5w1 + (size_t)g * 32768; const bf16_t* T = p.s5t + (size_t)g * 65536; const bf16_t* W2 = p.s5w2 + (size_t)g * 32768;
        bf16x8 Uf[8];
#pragma unroll
        for (int ks = 0; ks < 8; ++ks) Uf[ks] = *(const bf16x8*)(u + (unsigned)(((16 * w + lr) * 16 + 2 * ks + (lq >> 1)) * 16 + 8 * (lq & 1)));
        const f32x4 d4 = *(const f32x4*)(p.dskip + g * 16 + 4 * lq);
        const float ar = p.a16[(g * 64 + lane) * 2], ai = p.a16[(g * 64 + lane) * 2 + 1];
#pragma unroll 1
        for (int hh = 0; hh < 2; ++hh) {
            u32x4 r4[4];
#pragma unroll
            for (int r = 0; r < 4; ++r) { const int ci = tid + 512 * r; r4[r] = *(const u32x4*)(W1 + (unsigned)((hh * 64 + (ci >> 5)) * 256 + (ci & 31) * 8)); }
            __syncthreads();
#pragma unroll
            for (int r = 0; r < 4; ++r) { const int ci = tid + 512 * r; *(LAS u32x4*)(SA + (ci >> 5) * 264 + (ci & 31) * 8) = r4[r]; }
            __syncthreads();
#pragma unroll
            for (int n4 = 0; n4 < 4; ++n4) {
                f32x4 e = (f32x4){0.f, 0.f, 0.f, 0.f};
#pragma unroll
                for (int ks = 0; ks < 8; ++ks) e = mfma16(Uf[ks], *(const LAS bf16x8*)(SA + (n4 * 16 + lr) * 264 + ks * 32 + lq * 8), e);
                const int nt = hh * 4 + n4;
#pragma unroll
                for (int i = 0; i < 4; ++i) Es[(16 * w + 4 * lq + i) * 132 + nt * 16 + lr] = e[i];
                __builtin_amdgcn_sched_barrier(0);
            }
        }
        __syncthreads();
        {
            float hr = 0.f, hi = 0.f;
#pragma unroll
            for (int c = 0; c < 16; ++c) {
                const float er = Es[(16 * w + c) * 132 + lane], ei = Es[(16 * w + c) * 132 + 64 + lane];
                const float nr = ar * hr - ai * hi + er, ni = ar * hi + ai * hr + ei; hr = nr; hi = ni;
            }
            wsum[w * 128 + lane] = hr; wsum[w * 128 + 64 + lane] = hi;
        }
        __syncthreads();
        {
            float pr = ar, pi = ai;
#pragma unroll
            for (int i = 0; i < 4; ++i) { const float nr = pr * pr - pi * pi, ni = 2.0f * pr * pi; pr = nr; pi = ni; }
            float hr = 0.f, hi = 0.f;
            for (int w2 = 0; w2 < w; ++w2) {
                const float lr_ = wsum[w2 * 128 + lane], li_ = wsum[w2 * 128 + 64 + lane];
                const float nr = pr * hr - pi * hi + lr_, ni = pr * hi + pi * hr + li_; hr = nr; hi = ni;
            }
#pragma unroll
            for (int c = 0; c < 16; ++c) {
                Hp[(16 * w + c) * 136 + lane] = f2bf(hr); Hp[(16 * w + c) * 136 + 64 + lane] = f2bf(hi);
                const float er = Es[(16 * w + c) * 132 + lane], ei = Es[(16 * w + c) * 132 + 64 + lane];
                const float nr = ar * hr - ai * hi + er, ni = ar * hi + ai * hr + ei; hr = nr; hi = ni;
            }
        }
        u32x4 t4[8], w4[4]; u32x2 uu[8];
        const bf16_t* up = u + (size_t)((16 * w + lr) * 16) * 16 + 4 * lq;
#pragma unroll
        for (int r = 0; r < 8; ++r) { const int ci = tid + 512 * r; t4[r] = *(const u32x4*)(T + (unsigned)((ci >> 5) * 256 + (ci & 31) * 8)); }
#pragma unroll
        for (int r = 0; r < 4; ++r) { const int ci = tid + 512 * r; w4[r] = *(const u32x4*)(W2 + (unsigned)((ci >> 4) * 128 + (ci & 15) * 8)); }
#pragma unroll
        for (int nt = 0; nt < 8; ++nt) { uu[nt] = *(const u32x2*)(up); up += 16; asm volatile("" : "+v"(up)); }
        __syncthreads();
        bf16x8 Hf[4];
#pragma unroll
        for (int ks = 0; ks < 4; ++ks) Hf[ks] = *(const LAS bf16x8*)(Hp + (16 * w + lr) * 136 + ks * 32 + lq * 8);
        bf16_t* yp = yo + (size_t)((16 * w + lr) * 16) * DM + 4 * lq;
#pragma unroll
        for (int hh = 0; hh < 2; ++hh) {
            if (hh == 1) {
                __syncthreads();
#pragma unroll
                for (int r = 0; r < 8; ++r) { const int ci = tid + 512 * r; t4[r] = *(const u32x4*)(T + (unsigned)((128 + (ci >> 5)) * 256 + (ci & 31) * 8)); }
#pragma unroll
                for (int r = 0; r < 4; ++r) { const int ci = tid + 512 * r; w4[r] = *(const u32x4*)(W2 + (unsigned)((128 + (ci >> 4)) * 128 + (ci & 15) * 8)); }
#pragma unroll
                for (int nt = 0; nt < 8; ++nt) { uu[nt] = *(const u32x2*)(up); up += 16; asm volatile("" : "+v"(up)); }
            }
#pragma unroll
            for (int r = 0; r < 8; ++r) { const int ci = tid + 512 * r; *(LAS u32x4*)(Tl + (ci >> 5) * 264 + (ci & 31) * 8) = t4[r]; }
#pragma unroll
            for (int r = 0; r < 4; ++r) { const int ci = tid + 512 * r; *(LAS u32x4*)(SA + (ci >> 4) * 136 + (ci & 15) * 8) = w4[r]; }
            __syncthreads();
#pragma unroll
            for (int n8 = 0; n8 < 8; ++n8) {
                f32x4 y = (f32x4){0.f, 0.f, 0.f, 0.f};
#pragma unroll
                for (int ks = 0; ks < 8; ++ks) if (ks <= ((hh * 8 + n8) >> 1)) y = mfma16(*(const LAS bf16x8*)(Tl + (n8 * 16 + lr) * 264 + ks * 32 + lq * 8), Uf[ks], y);
#pragma unroll
                for (int ks = 0; ks < 4; ++ks) y = mfma16(*(const LAS bf16x8*)(SA + (n8 * 16 + lr) * 136 + ks * 32 + lq * 8), Hf[ks], y);
                const u32x2 u2 = uu[n8];
                f32x4 r;
                r[0] = geluf_(y[0] + d4[0] * blo(u2.x)); r[1] = geluf_(y[1] + d4[1] * bhi(u2.x));
                r[2] = geluf_(y[2] + d4[2] * blo(u2.y)); r[3] = geluf_(y[3] + d4[3] * bhi(u2.y));
                *(u32x2*)(yp) = pack4(r); yp += DM; asm volatile("" : "+v"(yp));
                __builtin_amdgcn_sched_barrier(0);
            }
        }
        __syncthreads();
    }
}

__device__ __forceinline__ void g2_phase(const P& p, int layer, int en, LAS unsigned char* lds) {
    for (int half = 0; half < 2; ++half) {
        EpiOutLn E; E.res = layer == 0 ? p.x : p.xf; E.dst = layer == 3 ? p.out : p.xf; E.xb = p.xb; E.g = p.ln_g[layer]; E.bb = p.ln_b[layer];
        E.X = p.lnx + (size_t)layer * 128 * 4 * 256 * 2; E.cnt = p.lncnt + layer * 128; E.pm_off = half * 64; E.use_acc = en; E.last = layer == 3;
        gemm_phase(lds, p.xb + (size_t)half * 16384 * DM, p.wt_out[layer], 16384, 1024, 1024, E);
    }
}

__global__ void __launch_bounds__(512, 2) fwd(P p) {
    extern __shared__ __attribute__((aligned(16))) unsigned char shm[];
    LAS unsigned char* lds = (LAS unsigned char*)shm;
    cg::grid_group grid = cg::this_grid();
    volatile LAS unsigned* xst = (volatile LAS unsigned*)(lds + 152576);
    if (threadIdx.x == 0) { xst[0] = 0u; xst[1] = 0u; }
    __syncthreads();
    const XcdBarrier xb = xcd_barrier_post(p.bar, xst);
    if (p.ph_hi < 0) grid.sync();
#ifndef DUP
#define DUP -1
#endif
#define PHASE(k, body) if (p.ph_lo <= (k) && (k) < p.ph_hi) { if ((k) > p.ph_lo) { xcd_barrier(xb); } if (PH_ON(k)) { body } if ((k) == DUP) { grid.sync(); body } }
#define HG1(L) { EpiHgrn E; E.q = p.s[0]; E.lf = p.out; E.v = p.s[2]; E.sg = p.s[3]; E.lb = p.lb + (L) * 1024; gemm_phase(lds, p.xb, p.wt_in[L], NTOK, 4096, 1024, E); }
    PHASE(0, prologue(p, lds);)
    PHASE(1, if (EN_L0) HG1(0))
    PHASE(2, if (EN_L0) hgrn_scan(p, 0, lds); if (gridDim.x >= 256) { if (blockIdx.x >= 128) prologue_b(p, (int)blockIdx.x - 128, (int)gridDim.x - 128, lds); } else prologue_b(p, (int)blockIdx.x, (int)gridDim.x, lds);)
    PHASE(3, g2_phase(p, 0, EN_L0, lds);)
    PHASE(5, if (EN_L1) { EpiMoba E; E.q = p.s[0]; E.k = p.s[1]; E.v = p.s[2]; E.sg = p.s[3]; E.rope = p.rope; E.kmean = p.kmean; gemm_phase(lds, p.xb, p.wt_in[1], NTOK, 4096, 1024, E); })
    PHASE(6, if (EN_L1) moba_phase(p, lds);)
    PHASE(7, g2_phase(p, 1, EN_L1, lds);)
    PHASE(9, if (EN_L2) { EpiS5 E; E.u = p.s[0]; E.sg = p.s[3]; gemm_phase(lds, p.xb, p.wt_in[2], NTOK, 2048, 1024, E); })
    PHASE(10, if (EN_L2) s5_scan(p, lds);)
    PHASE(11, if (EN_L2) { EpiGlu E; E.y = p.s[1]; E.sg = p.s[3]; E.bias = p.b_glu; E.o = p.xb; gemm_phase(lds, p.s[1], p.wt_glu, NTOK, 1024, 1024, E); })
    PHASE(12, g2_phase(p, 2, EN_L2, lds);)
    PHASE(14, if (EN_L3) HG1(3))
    PHASE(15, if (EN_L3) hgrn_scan(p, 3, lds);)
    PHASE(16, g2_phase(p, 3, EN_L3, lds);)
#ifdef SYNC_PROBE
    for (int i = 0; i < 8; ++i) grid.sync();
#endif
}

extern "C" void kernel_launch(void* const* d_in, const int* in_sizes, int n_in, void* d_out, int out_size, void* d_ws, size_t ws_size, hipStream_t stream) {
    static int grid_blocks = 0;
    if (!grid_blocks) {
        int dev = 0, cus = 0, per_cu = 0;
        hipGetDevice(&dev);
        hipDeviceGetAttribute(&cus, hipDeviceAttributeMultiprocessorCount, dev);
        hipFuncSetAttribute((const void*)fwd, hipFuncAttributeMaxDynamicSharedMemorySize, LDS_BYTES);
        hipOccupancyMaxActiveBlocksPerMultiprocessor(&per_cu, (const void*)fwd, 512, LDS_BYTES);
        if (per_cu < 1) { fprintf(stderr, "kernel_launch: occupancy query says %d blocks/CU\n", per_cu); per_cu = 1; }
        grid_blocks = cus * 1;
        (void)hipGetLastError();
    }
    P p{};
    const float* const* in = (const float* const*)d_in;
    p.x = in[0]; p.lbl = in[1];
    p.w_in[0] = in[2]; p.norm_g[0] = in[3]; p.w_out[0] = in[4]; p.ln_g[0] = in[5]; p.ln_b[0] = in[6];
    p.w_in[1] = in[7]; p.w_out[1] = in[8]; p.ln_g[1] = in[9]; p.ln_b[1] = in[10]; p.norm_g[1] = in[3];
    p.w_in[2] = in[11]; p.a_re = in[12]; p.a_im = in[13]; p.log_dt = in[14]; p.b_re = in[15]; p.b_im = in[16]; p.c_re = in[17]; p.c_im = in[18];
    p.dskip = in[19]; p.w_glu = in[20]; p.b_glu = in[21]; p.w_out[2] = in[22]; p.ln_g[2] = in[23]; p.ln_b[2] = in[24]; p.norm_g[2] = in[3];
    p.w_in[3] = in[25]; p.norm_g[3] = in[26]; p.w_out[3] = in[27]; p.ln_g[3] = in[28]; p.ln_b[3] = in[29];
    p.out = (float*)d_out;
    unsigned char* ws = (unsigned char*)d_ws; size_t off = 0;
    auto take = [&](size_t bytes) { unsigned char* r = ws + off; off += (bytes + 255) & ~(size_t)255; return r; };
    const size_t MD2 = (size_t)NTOK * DM * 2;
    p.xb = (bf16_t*)take(MD2); p.xf = (float*)take(MD2 * 2);
    for (int i = 0; i < 4; ++i) p.s[i] = (bf16_t*)take(MD2);
    p.wt_in[0] = (bf16_t*)take(4096 * 1024 * 2); p.wt_in[1] = (bf16_t*)take(4096 * 1024 * 2); p.wt_in[2] = (bf16_t*)take(2048 * 1024 * 2); p.wt_in[3] = (bf16_t*)take(4096 * 1024 * 2);
    for (int i = 0; i < 4; ++i) p.wt_out[i] = (bf16_t*)take(1024 * 1024 * 2);
    p.wt_glu = (bf16_t*)take(1024 * 1024 * 2);
    p.s5w1 = (bf16_t*)take(64 * 32768 * 2); p.s5t = (bf16_t*)take(64 * 65536 * 2); p.s5w2 = (bf16_t*)take(64 * 32768 * 2);
    p.lb = (float*)take(4096 * 4); p.rope = (float*)take(SEQ * 64 * 2 * 4); p.kmean = (float*)take(16 * 8 * 8 * 128 * 4); p.a16 = (float*)take(64 * 64 * 2 * 4); p.lnx = (float*)take(4 * 128 * 4 * 256 * 2 * 4); p.lncnt = (unsigned*)take(512 * 4); p.bar = (unsigned*)take(XCD_BAR_WORDS * 4);
    if (off > ws_size) { fprintf(stderr, "kernel_launch: workspace too small: need %zu have %zu\n", off, ws_size); return; }
    (void)hipMemsetAsync(p.bar, 0, XCD_BAR_WORDS * 4, stream);
#if MODE_SINGLE
    p.ph_lo = 0; p.ph_hi = NPHASE;
    void* args[] = {&p};
    hipError_t e = hipLaunchCooperativeKernel((const void*)fwd, dim3(grid_blocks), dim3(512), args, LDS_BYTES, stream);
    if (e != hipSuccess) fprintf(stderr, "cooperative launch failed: %s (grid %d)\n", hipGetErrorString(e), grid_blocks);
#else
    for (int ph = 0; ph < NPHASE; ++ph) {
        p.ph_lo = ph; p.ph_hi = ph + 1;
        hipLaunchKernelGGL(fwd, dim3(grid_blocks), dim3(512), LDS_BYTES, stream, p);
    }
#endif
}
```
